# Optimizing an MI355X kernel written in HIP

```python
import math
import jax, jax.numpy as jnp
from jax import lax
import numpy as np

D_MODEL = 1024
BATCH = 4
SEQ = 4096
DEPTH = 1

DA_HEADS = 4
DA_QK_DIM = 64
DA_V_DIM = 2 * DA_QK_DIM
SB_HEADS = 4
SB_HEAD_DIM = 128
D_FF = 2816
Q_BLOCK = 128
NORM_EPS = 1e-5
N_BRANCHES = 2
DA_QK_WIDTH = DA_HEADS * 2 * DA_QK_DIM
DA_V_WIDTH = DA_HEADS * DA_V_DIM
SB_WIDTH = SB_HEADS * SB_HEAD_DIM
IN_SPLITS = (DA_QK_WIDTH, DA_QK_WIDTH, DA_V_WIDTH, SB_WIDTH, SB_WIDTH, SB_WIDTH, N_BRANCHES * D_MODEL)
D_IN = sum(IN_SPLITS)
IN_SPLIT_POINTS = [int(v) for v in np.cumsum(IN_SPLITS)[:-1]]

kernel_name = "hybrid_gated_diffattn_stickbreak_macaron"


def rmsnorm(x, g):
    xf = x.astype(jnp.float32)
    y = xf * lax.rsqrt(jnp.mean(xf * xf, axis=-1, keepdims=True) + NORM_EPS)
    return (y * g.astype(jnp.float32)).astype(x.dtype)


def swiglu(x, w_gate, w_up, w_down):
    return (jax.nn.silu(x @ w_gate) * (x @ w_up)) @ w_down


def alibi_slopes(n_heads):
    return jnp.exp2(-8.0 * jnp.arange(1, n_heads + 1, dtype=jnp.float32) / n_heads)


def lambda_init_fn(layer_idx):
    return 0.8 - 0.6 * math.exp(-0.3 * layer_idx)


def diff_attention(q, k, v, lam):
    B, H, _, S, _ = q.shape
    dv = v.shape[-1]
    n_blocks = S // Q_BLOCK
    scale = DA_QK_DIM ** -0.5
    slopes = alibi_slopes(H)[:, None, None, None]
    k_pos = jnp.arange(S)

    def block(i):
        start = i * Q_BLOCK
        qb = lax.dynamic_slice_in_dim(q, start, Q_BLOCK, axis=3)
        q_pos = start + jnp.arange(Q_BLOCK)
        dist = q_pos[:, None] - k_pos[None, :]
        causal = dist >= 0
        s = jnp.einsum('bhmqd,bhmkd->bhmqk', qb, k).astype(jnp.float32) * scale
        s = s - slopes * dist.astype(jnp.float32)
        s = jnp.where(causal, s, -jnp.inf)
        p = jax.nn.softmax(s, axis=-1)
        w = p[:, :, 0] - lam * p[:, :, 1]
        return jnp.einsum('bhqk,bhkd->bhqd', w.astype(v.dtype), v)

    out = lax.map(block, jnp.arange(n_blocks))
    return jnp.moveaxis(out, 0, 2).reshape(B, H, S, dv)


def stick_breaking_attention(q, k, v):
    B, H, S, d = q.shape
    n_blocks = S // Q_BLOCK
    scale = d ** -0.5
    k_pos = jnp.arange(S)

    def block(i):
        start = i * Q_BLOCK
        qb = lax.dynamic_slice_in_dim(q, start, Q_BLOCK, axis=2)
        q_pos = start + jnp.arange(Q_BLOCK)
        strict = k_pos[None, :] < q_pos[:, None]
        z = jnp.einsum('bhqd,bhkd->bhqk', qb, k).astype(jnp.float32) * scale
        u = jnp.where(strict, jax.nn.softplus(z), 0.0)
        tail = lax.cumsum(u, axis=3, reverse=True) - u
        log_a = jax.nn.log_sigmoid(z) - tail
        a = jnp.where(strict, jnp.exp(log_a), 0.0)
        return jnp.einsum('bhqk,bhkd->bhqd', a.astype(v.dtype), v)

    out = lax.map(block, jnp.arange(n_blocks))
    return jnp.moveaxis(out, 0, 2).reshape(B, H, S, d)


def gated_mixer(xn, w_in, b_gate, lambda_q1, lambda_k1, lambda_q2, lambda_k2,
                diff_subln, w_branch_diff, w_branch_sb, w_out, lam_init):
    B, S, _ = xn.shape
    proj = xn @ w_in
    da_q, da_k, da_v, sb_q, sb_k, sb_v, gate_logits = jnp.split(proj, IN_SPLIT_POINTS, axis=-1)

    da_q = da_q.reshape(B, S, DA_HEADS, 2, DA_QK_DIM).transpose(0, 2, 3, 1, 4)
    da_k = da_k.reshape(B, S, DA_HEADS, 2, DA_QK_DIM).transpose(0, 2, 3, 1, 4)
    da_v = da_v.reshape(B, S, DA_HEADS, DA_V_DIM).transpose(0, 2, 1, 3)
    lam = (jnp.exp(jnp.sum(lambda_q1.astype(jnp.float32) * lambda_k1.astype(jnp.float32)))
           - jnp.exp(jnp.sum(lambda_q2.astype(jnp.float32) * lambda_k2.astype(jnp.float32)))
           + lam_init)
    a = diff_attention(da_q, da_k, da_v, lam)
    a = rmsnorm(a, diff_subln) * (1.0 - lam_init)
    a = a.transpose(0, 2, 1, 3).reshape(B, S, DA_V_WIDTH)

    sb_q = sb_q.reshape(B, S, SB_HEADS, SB_HEAD_DIM).transpose(0, 2, 1, 3)
    sb_k = sb_k.reshape(B, S, SB_HEADS, SB_HEAD_DIM).transpose(0, 2, 1, 3)
    sb_v = sb_v.reshape(B, S, SB_HEADS, SB_HEAD_DIM).transpose(0, 2, 1, 3)
    b = stick_breaking_attention(sb_q, sb_k, sb_v)
    b = b.transpose(0, 2, 1, 3).reshape(B, S, SB_WIDTH)

    gates = jax.nn.sigmoid(gate_logits + b_gate).reshape(B, S, N_BRANCHES, D_MODEL)
    y = gates[:, :, 0] * (a @ w_branch_diff) + gates[:, :, 1] * (b @ w_branch_sb)
    return y @ w_out


def setup_inputs(seed: int = 0) -> dict:
    key = jax.random.key(seed)
    ks = jax.random.split(key, 24)
    f32 = jnp.float32
    L = DEPTH

    def w(k, shape, fan_in):
        return jax.random.normal(k, shape, f32) * fan_in ** -0.5

    def gain(k, shape):
        return 1.0 + 0.01 * jax.random.normal(k, shape, f32)

    return {
        "x": jax.random.normal(ks[0], (BATCH, SEQ, D_MODEL), f32),
        "ffn1_norm": gain(ks[1], (L, D_MODEL)),
        "ffn1_w_gate": w(ks[2], (L, D_MODEL, D_FF), D_MODEL),
        "ffn1_w_up": w(ks[3], (L, D_MODEL, D_FF), D_MODEL),
        "ffn1_w_down": w(ks[4], (L, D_FF, D_MODEL), D_FF),
        "mix_norm": gain(ks[5], (L, D_MODEL)),
        "w_in": w(ks[6], (L, D_MODEL, D_IN), D_MODEL),
        "b_gate": 0.01 * jax.random.normal(ks[7], (L, N_BRANCHES * D_MODEL), f32),
        "lambda_q1": 0.1 * jax.random.normal(ks[8], (L, DA_QK_DIM), f32),
        "lambda_k1": 0.1 * jax.random.normal(ks[9], (L, DA_QK_DIM), f32),
        "lambda_q2": 0.1 * jax.random.normal(ks[10], (L, DA_QK_DIM), f32),
        "lambda_k2": 0.1 * jax.random.normal(ks[11], (L, DA_QK_DIM), f32),
        "diff_subln": gain(ks[12], (L, DA_V_DIM)),
        "w_branch_diff": w(ks[13], (L, DA_V_WIDTH, D_MODEL), DA_V_WIDTH),
        "w_branch_sb": w(ks[14], (L, SB_WIDTH, D_MODEL), SB_WIDTH),
        "w_out": w(ks[15], (L, D_MODEL, D_MODEL), D_MODEL),
        "ffn2_norm": gain(ks[16], (L, D_MODEL)),
        "ffn2_w_gate": w(ks[17], (L, D_MODEL, D_FF), D_MODEL),
        "ffn2_w_up": w(ks[18], (L, D_MODEL, D_FF), D_MODEL),
        "ffn2_w_down": w(ks[19], (L, D_FF, D_MODEL), D_FF),
        "final_norm": gain(ks[20], (D_MODEL,)),
    }


def reference(x, ffn1_norm, ffn1_w_gate, ffn1_w_up, ffn1_w_down, mix_norm, w_in, b_gate,
              lambda_q1, lambda_k1, lambda_q2, lambda_k2, diff_subln, w_branch_diff,
              w_branch_sb, w_out, ffn2_norm, ffn2_w_gate, ffn2_w_up, ffn2_w_down, final_norm):
    h = x
    for l in range(DEPTH):
        lam_init = lambda_init_fn(l)
        h = h + 0.5 * swiglu(rmsnorm(h, ffn1_norm[l]), ffn1_w_gate[l], ffn1_w_up[l], ffn1_w_down[l])
        h = h + gated_mixer(rmsnorm(h, mix_norm[l]), w_in[l], b_gate[l],
                            lambda_q1[l], lambda_k1[l], lambda_q2[l], lambda_k2[l],
                            diff_subln[l], w_branch_diff[l], w_branch_sb[l], w_out[l], lam_init)
        h = h + 0.5 * swiglu(rmsnorm(h, ffn2_norm[l]), ffn2_w_gate[l], ffn2_w_up[l], ffn2_w_down[l])
    return rmsnorm(h, final_norm)
```

```cpp
#include <hip/hip_runtime.h>
#include <hip/hip_cooperative_groups.h>
#include <cstdio>
#include <cstdint>
namespace cg = cooperative_groups;
namespace pg8 {
#define PG8_LAS __attribute__((address_space(3)))
typedef unsigned short bf16_t;
typedef short bf16x8 __attribute__((ext_vector_type(8)));
typedef float f32x4 __attribute__((ext_vector_type(4)));
typedef unsigned u32x4 __attribute__((ext_vector_type(4)));
constexpr int BM = 256, BK = 64, HALF = 128, HTB = HALF * BK * 2  , STAGE_BYTES = 8 * HTB, NXCD = 8, WGM = 8;

__host__ __device__ __forceinline__ int lds_byte(int r, int c) { const int st = (r >> 4) * 2 + (c >> 5), rr = r & 15, cc = c & 31, ob = rr * 64 + cc * 2; return st * 1024 + (ob ^ (((ob >> 9) & 1) << 5)); }
__host__ __device__ __forceinline__ void stage_rc(int b, int& R, int& C) { const int st = b / 1024, sb = b % 1024, swz = sb ^ (((sb >> 9) & 1) << 5); R = (st >> 1) * 16 + swz / 64; C = (st & 1) * 32 + (swz % 64) / 2; }
__host__ __device__ __forceinline__ int perm32(int rho) { const int n = rho >> 4, i = rho & 15; return 8 * (i >> 2) + 4 * n + (i & 3); }

struct Unit { int pm, pn; };
struct Gemm { const bf16_t* A; const bf16_t* Bt; int M, N, K; };

struct StaticOrder {
    int nM, nN, nwg, G, c;
    __host__ __device__ void init(int M, int N, int G_, int c_) { nM = M / BM; nN = N / BM; nwg = nM * nN; G = G_; c = c_; }
    __host__ __device__ bool next(int i, Unit& u) const {
        const long L = (long)i * G + c; if (L >= nwg) return false;
        int wgid = (int)L; { const int q = nwg / NXCD, r = nwg % NXCD, xcd = wgid % NXCD, off = wgid / NXCD; wgid = (xcd < r ? xcd * (q + 1) : r * (q + 1) + (xcd - r) * q) + off; }
        const int nig = WGM * nN, gid = wgid / nig, fm = gid * WGM, gsz = (nM - fm) < WGM ? (nM - fm) : WGM;
        u.pm = fm + ((wgid % nig) % gsz); u.pn = (wgid % nig) / gsz; return true;
    }
    __device__ __forceinline__ void a_ready(const Unit&) const {}
    __device__ __forceinline__ void done(const Unit&) const {}
};
__device__ __forceinline__ unsigned cvt_pk_bf16(float lo, float hi) { unsigned r; asm volatile("v_cvt_pk_bf16_f32 %0, %1, %2" : "=v"(r) : "v"(lo), "v"(hi)); return r; }
typedef float f32x2 __attribute__((ext_vector_type(2)));
typedef unsigned u32x2 __attribute__((ext_vector_type(2)));
constexpr float NORM_EPS_ = 1e-5f;
__device__ __forceinline__ float row_rstd(const float* ss, int row, int fq) {
    const f32x4 a = ((const f32x4*)(ss + (size_t)row * 16))[fq];
    float s = (a[0] + a[1]) + (a[2] + a[3]);
    s += __shfl_xor(s, 16); s += __shfl_xor(s, 32);
    return __builtin_amdgcn_rsqf(s * (1.0f / 1024.0f) + NORM_EPS_); }
__device__ __forceinline__ float fast_sigmoid(float v) { return __builtin_amdgcn_rcpf(1.0f + __builtin_amdgcn_exp2f(-1.4426950408889634f * v)); }
__device__ __forceinline__ float bf_lo(unsigned w) { return __builtin_bit_cast(float, w << 16); }
__device__ __forceinline__ float bf_hi(unsigned w) { return __builtin_bit_cast(float, w & 0xffff0000u); }

struct EpiSwiGLU {
    static constexpr bool PERM = true, AFTER_DRAIN = false;
    bf16_t* U; int ldu; const float* ss;
    __device__ __forceinline__ void operator()(const f32x4 (&acc)[2][2][4][2], const Unit& u, int wr, int wc, int fr, int fq) const {
        const int row0 = u.pm * BM + wr * 64 + fr, col0 = u.pn * HALF + wc * 32 + 8 * fq;
#pragma unroll
        for (int ai = 0; ai < 2; ++ai)
#pragma unroll
            for (int m = 0; m < 4; ++m) {
                const int row = row0 + ai * HALF + m * 16; const float r = row_rstd(ss, row, fq);
                float o[8];
#pragma unroll
                for (int n = 0; n < 2; ++n)
#pragma unroll
                    for (int e = 0; e < 4; ++e) { const float g = acc[ai][0][m][n][e] * r, up = acc[ai][1][m][n][e] * r; o[n * 4 + e] = g * fast_sigmoid(g) * up; }
                u32x4 w; w.x = cvt_pk_bf16(o[0], o[1]); w.y = cvt_pk_bf16(o[2], o[3]); w.z = cvt_pk_bf16(o[4], o[5]); w.w = cvt_pk_bf16(o[6], o[7]);
                *(u32x4*)(U + (size_t)row * ldu + col0) = w;
            }
    }
};

struct EpiResid {
    static constexpr bool PERM = false, AFTER_DRAIN = false;
    const float* base; float* out; bf16_t* hb; float* ssq; float alpha;
    __device__ __forceinline__ void operator()(const f32x4 (&acc)[2][2][4][2], const Unit& u, int wr, int wc, int fr, int fq) const {
        const int row0 = u.pm * BM + wr * 64 + fr, col0 = u.pn * BM + wc * 32 + 4 * fq;
#pragma unroll
        for (int ai = 0; ai < 2; ++ai)
#pragma unroll
            for (int m = 0; m < 4; ++m) {
                const int row = row0 + ai * HALF + m * 16; const size_t off = (size_t)row * 1024 + col0; float sq = 0.f;
#pragma unroll
                for (int bj = 0; bj < 2; ++bj)
#pragma unroll
                    for (int n = 0; n < 2; ++n) {
                        const f32x4 b = *(const f32x4*)(base + off + bj * HALF + n * 16);
                        const f32x4 v = b + acc[ai][bj][m][n] * alpha;
                        *(f32x4*)(out + off + bj * HALF + n * 16) = v;
                        sq += (v[0] * v[0] + v[1] * v[1]) + (v[2] * v[2] + v[3] * v[3]);
                        if (hb) { u32x2 w; w.x = cvt_pk_bf16(v[0], v[1]); w.y = cvt_pk_bf16(v[2], v[3]); *(u32x2*)(hb + off + bj * HALF + n * 16) = w; }
                    }
                sq += __shfl_xor(sq, 16); sq += __shfl_xor(sq, 32);
                if (fq == 0) ssq[(size_t)row * 16 + u.pn * 4 + wc] = sq;
            }
    }
};

struct EpiResidB {
    static constexpr bool PERM = true, AFTER_DRAIN = false;
    const float* basef; bf16_t* hb; float* ssq; float alpha;
    __device__ __forceinline__ void operator()(const f32x4 (&acc)[2][2][4][2], const Unit& u, int wr, int wc, int fr, int fq) const {
        const int row0 = u.pm * BM + wr * 64 + fr, col0 = u.pn * BM + wc * 32 + 8 * fq;
#pragma unroll
        for (int ai = 0; ai < 2; ++ai) {
            u32x4 bh[4][2];
#pragma unroll
            for (int m = 0; m < 4; ++m)
#pragma unroll
                for (int bj = 0; bj < 2; ++bj) bh[m][bj] = *(const u32x4*)(hb + (size_t)(row0 + ai * HALF + m * 16) * 1024 + col0 + bj * HALF);
#pragma unroll
            for (int m = 0; m < 4; ++m) {
                const int row = row0 + ai * HALF + m * 16; const size_t off = (size_t)row * 1024 + col0; float sq = 0.f;
#pragma unroll
                for (int bj = 0; bj < 2; ++bj) {
                    const u32x4 p = bh[m][bj];
                    const f32x4 b0 = (f32x4){bf_lo(p.x), bf_hi(p.x), bf_lo(p.y), bf_hi(p.y)}, b1 = (f32x4){bf_lo(p.z), bf_hi(p.z), bf_lo(p.w), bf_hi(p.w)};
                    const f32x4 v0 = b0 + acc[ai][bj][m][0] * alpha, v1 = b1 + acc[ai][bj][m][1] * alpha;
                    sq += ((v0[0] * v0[0] + v0[1] * v0[1]) + (v0[2] * v0[2] + v0[3] * v0[3])) + ((v1[0] * v1[0] + v1[1] * v1[1]) + (v1[2] * v1[2] + v1[3] * v1[3]));
                    u32x4 w; w.x = cvt_pk_bf16(v0[0], v0[1]); w.y = cvt_pk_bf16(v0[2], v0[3]); w.z = cvt_pk_bf16(v1[0], v1[1]); w.w = cvt_pk_bf16(v1[2], v1[3]);
                    *(u32x4*)(hb + off + bj * HALF) = w;
                }
                sq += __shfl_xor(sq, 16); sq += __shfl_xor(sq, 32);
                if (fq == 0) ssq[(size_t)row * 16 + u.pn * 4 + wc] = sq;
            }
        }
    }
};

struct EpiProj {
    static constexpr bool PERM = true, AFTER_DRAIN = false;
    bf16_t* qkv; bf16_t* gates; const float* ss; const float* bgate; float sc_da, sc_sb;
    __device__ __forceinline__ void operator()(const f32x4 (&acc)[2][2][4][2], const Unit& u, int wr, int wc, int fr, int fq) const {
        const int row0 = u.pm * BM + wr * 64 + fr;
        if (u.pn >= 8) {
            const int t = (u.pn - 8) >> 1; const float sc = (t == 0) ? sc_da : ((t == 3) ? sc_sb : 1.0f);
            bf16_t* dst = qkv + (size_t)t * ((size_t)16384 * 512); const int col0 = ((u.pn - 8) & 1) * BM + wc * 32 + 8 * fq;
#pragma unroll
            for (int ai = 0; ai < 2; ++ai)
#pragma unroll
                for (int m = 0; m < 4; ++m) {
                    const int row = row0 + ai * HALF + m * 16; const float r = row_rstd(ss, row, fq) * sc;
#pragma unroll
                    for (int bj = 0; bj < 2; ++bj) {
                        const f32x4 v0 = acc[ai][bj][m][0] * r, v1 = acc[ai][bj][m][1] * r;
                        u32x4 w; w.x = cvt_pk_bf16(v0[0], v0[1]); w.y = cvt_pk_bf16(v0[2], v0[3]); w.z = cvt_pk_bf16(v1[0], v1[1]); w.w = cvt_pk_bf16(v1[2], v1[3]);
                        *(u32x4*)(dst + (size_t)row * 512 + col0 + bj * HALF) = w;
                    }
                }
        } else {
            const int col0 = u.pn * BM + wc * 32 + 8 * fq;
            f32x4 bv[2][2];
#pragma unroll
            for (int bj = 0; bj < 2; ++bj)
#pragma unroll
                for (int n = 0; n < 2; ++n) bv[bj][n] = *(const f32x4*)(bgate + col0 + bj * HALF + 4 * n);
#pragma unroll
            for (int ai = 0; ai < 2; ++ai)
#pragma unroll
                for (int m = 0; m < 4; ++m) {
                    const int row = row0 + ai * HALF + m * 16; const float r = row_rstd(ss, row, fq);
#pragma unroll
                    for (int bj = 0; bj < 2; ++bj) {
                        float o[8];
#pragma unroll
                        for (int n = 0; n < 2; ++n)
#pragma unroll
                            for (int e = 0; e < 4; ++e) o[n * 4 + e] = fast_sigmoid(acc[ai][bj][m][n][e] * r + bv[bj][n][e]);
                        u32x4 w; w.x = cvt_pk_bf16(o[0], o[1]); w.y = cvt_pk_bf16(o[2], o[3]); w.z = cvt_pk_bf16(o[4], o[5]); w.w = cvt_pk_bf16(o[6], o[7]);
                        *(u32x4*)(gates + (size_t)row * 2048 + col0 + bj * HALF) = w;
                    }
                }
        }
    }
};

struct EpiBranch2 {
    static constexpr bool PERM = true, AFTER_DRAIN = false;
    bf16_t* y; const bf16_t* gates;
    __device__ __forceinline__ void operator()(const f32x4 (&acc)[2][2][4][2], const Unit& u, int wr, int wc, int fr, int fq) const {
        const int row0 = u.pm * BM + wr * 64 + fr, col0 = u.pn * HALF + wc * 32 + 8 * fq;
#pragma unroll
        for (int ai = 0; ai < 2; ++ai)
#pragma unroll
            for (int m = 0; m < 4; ++m) {
                const int row = row0 + ai * HALF + m * 16;
                const u32x4 ga = *(const u32x4*)(gates + (size_t)row * 2048 + col0), gb = *(const u32x4*)(gates + (size_t)row * 2048 + 1024 + col0);
                const f32x4 a0 = acc[ai][0][m][0], a1 = acc[ai][0][m][1], b0 = acc[ai][1][m][0], b1 = acc[ai][1][m][1];
                u32x4 w;
                w.x = cvt_pk_bf16(bf_lo(ga.x) * a0[0] + bf_lo(gb.x) * b0[0], bf_hi(ga.x) * a0[1] + bf_hi(gb.x) * b0[1]);
                w.y = cvt_pk_bf16(bf_lo(ga.y) * a0[2] + bf_lo(gb.y) * b0[2], bf_hi(ga.y) * a0[3] + bf_hi(gb.y) * b0[3]);
                w.z = cvt_pk_bf16(bf_lo(ga.z) * a1[0] + bf_lo(gb.z) * b1[0], bf_hi(ga.z) * a1[1] + bf_hi(gb.z) * b1[1]);
                w.w = cvt_pk_bf16(bf_lo(ga.w) * a1[2] + bf_lo(gb.w) * b1[2], bf_hi(ga.w) * a1[3] + bf_hi(gb.w) * b1[3]);
                *(u32x4*)(y + (size_t)row * 1024 + col0) = w;
            }
    }
};
#ifndef PG8_EPI_DRAIN
#define PG8_EPI_DRAIN() do {} while (0)
#endif
template <class Epi, class Sched, bool ALIGN_EPI = false, bool SP2 = false>
__device__ __forceinline__ void gemm_phase(PG8_LAS unsigned char* lds, const Gemm g, const Sched& S, const Epi& E) {
    int tid_ = threadIdx.x; asm volatile("" : "+v"(tid_));
    const int tid = tid_, wid = __builtin_amdgcn_readfirstlane(tid >> 6), lane = tid & 63, wr = wid >> 2, wc = wid & 3, fr = lane & 15, fq = lane >> 4;
    const int K = g.K, nt = K / BK;
    unsigned voffA[2], voffB[2];
#pragma unroll
    for (int i = 0; i < 2; ++i) { int R, C; stage_rc(tid * 16 + i * 8192, R, C); const int Rb = Epi::PERM ? ((R & ~31) + perm32(R & 31)) : R;
        voffA[i] = (unsigned)(R * K + C) * 2u; voffB[i] = (unsigned)(Rb * K + C) * 2u; }
    const size_t kstep = (size_t)(BK * 2);
    const size_t hstep = (size_t)HALF * K * 2;
    const size_t tstep = 2 * hstep;
    const unsigned ldsw = (unsigned)wid * 1024u;
    const int aoff = lds_byte(wr * 64 + fr, fq * 8), boff = lds_byte(wc * 32 + fr, fq * 8);
#define PG8_SA(b, h) (((b) * 2 + (h)) * HTB)
#define PG8_SB(b, h) ((4 + (b) * 2 + (h)) * HTB)
#define PG8_STAGE(bufoff, gbase, voff) do { _Pragma("unroll") for (int _i = 0; _i < 2; ++_i) \
        __builtin_amdgcn_global_load_lds((const unsigned*)((const char*)(gbase) + (voff)[_i]), (PG8_LAS unsigned*)(lds + (bufoff) + ldsw + _i * 8192), 16, 0, 0); } while (0)
#define PG8_LDA(dst, b, h) do { _Pragma("unroll") for (int m = 0; m < 4; ++m) _Pragma("unroll") for (int k = 0; k < 2; ++k) dst[m][k] = *(const PG8_LAS bf16x8*)(lds + PG8_SA(b, h) + aoff + m * 2048 + k * 1024); } while (0)
#define PG8_LDB(dst, b, h) do { _Pragma("unroll") for (int n = 0; n < 2; ++n) _Pragma("unroll") for (int k = 0; k < 2; ++k) dst[n][k] = *(const PG8_LAS bf16x8*)(lds + PG8_SB(b, h) + boff + n * 2048 + k * 1024); } while (0)
#define PG8_MMA(ai, bj, At, Bt) do { __builtin_amdgcn_s_setprio(1); _Pragma("unroll") for (int m = 0; m < 4; ++m) _Pragma("unroll") for (int n = 0; n < 2; ++n) _Pragma("unroll") for (int k = 0; k < 2; ++k) \
        acc[ai][bj][m][n] = __builtin_amdgcn_mfma_f32_16x16x32_bf16(Bt[n][k], At[m][k], acc[ai][bj][m][n], 0, 0, 0); __builtin_amdgcn_s_setprio(0); } while (0)
#define PG8_WAIT_V(n) asm volatile("s_waitcnt vmcnt(" #n ")" ::: "memory")
#define PG8_WAIT_L(n) asm volatile("s_waitcnt lgkmcnt(" #n ")" ::: "memory")
#define PG8_BAR __builtin_amdgcn_s_barrier()
#define PG8_SCHED __builtin_amdgcn_sched_barrier(0)
    Unit cur, nxt; int ui = 0;
    if (!S.next(0, cur)) return;
    f32x4 acc[2][2][4][2];
#pragma unroll
    for (int a = 0; a < 2; ++a)
#pragma unroll
        for (int b = 0; b < 2; ++b)
#pragma unroll
            for (int m = 0; m < 4; ++m)
#pragma unroll
                for (int n = 0; n < 2; ++n) acc[a][b][m][n] = (f32x4){0.f, 0.f, 0.f, 0.f};
    bf16x8 At[4][2], B0[2][2], B1[2][2];
    const char* cA = (const char*)g.A + (size_t)cur.pm * tstep; const char* cB = (const char*)g.Bt + (size_t)cur.pn * tstep;
    S.a_ready(cur);
    if constexpr (SP2) {
        PG8_STAGE(PG8_SB(0, 0), cB, voffB); PG8_STAGE(PG8_SB(0, 1), cB + hstep, voffB); PG8_STAGE(PG8_SA(0, 0), cA, voffA); PG8_STAGE(PG8_SA(0, 1), cA + hstep, voffA);
        if (wr == 1) PG8_BAR;
        PG8_WAIT_V(2); PG8_BAR;
        PG8_STAGE(PG8_SB(1, 0), cB + kstep, voffB); PG8_STAGE(PG8_SA(1, 0), cA + kstep, voffA); PG8_STAGE(PG8_SB(1, 1), cB + hstep + kstep, voffB);
        PG8_WAIT_V(6); PG8_BAR;
    } else {
        PG8_STAGE(PG8_SB(0, 0), cB, voffB); PG8_STAGE(PG8_SA(0, 0), cA, voffA); PG8_STAGE(PG8_SB(0, 1), cB + hstep, voffB); PG8_STAGE(PG8_SA(0, 1), cA + hstep, voffA);
        if (wr == 1) PG8_BAR;
        PG8_WAIT_V(4); PG8_BAR;
        PG8_STAGE(PG8_SB(1, 0), cB + kstep, voffB); PG8_STAGE(PG8_SA(1, 0), cA + kstep, voffA); PG8_STAGE(PG8_SB(1, 1), cB + hstep + kstep, voffB);
        PG8_WAIT_V(6); PG8_BAR;
    }
    for (;;) {
        const bool has_next = S.next(ui + 1, nxt);
        const char* nA = has_next ? (const char*)g.A + (size_t)nxt.pm * tstep : cA; const char* nB = has_next ? (const char*)g.Bt + (size_t)nxt.pn * tstep : cB;
        for (int t = 0; t < nt; t += 2) {
            const bool last = (t == nt - 2);
            const char* a1 = cA + (size_t)(t + 1) * kstep;
            const char* a2 = last ? nA : cA + (size_t)(t + 2) * kstep; const char* b2 = last ? nB : cB + (size_t)(t + 2) * kstep;
            const char* a3 = a2 + kstep; const char* b3 = b2 + kstep;
            if (last && has_next) S.a_ready(nxt);
            if constexpr (SP2) {
            PG8_LDB(B0, 0, 0); PG8_LDB(B1, 0, 1); PG8_SCHED; PG8_LDA(At, 0, 0); PG8_STAGE(PG8_SA(1, 1), a1 + hstep, voffA);
            PG8_WAIT_V(8); PG8_WAIT_L(0); PG8_BAR; PG8_MMA(0, 0, At, B0); PG8_MMA(0, 1, At, B1); PG8_BAR; PG8_SCHED;
            PG8_LDA(At, 0, 1); PG8_STAGE(PG8_SB(0, 0), b2, voffB); PG8_STAGE(PG8_SB(0, 1), b2 + hstep, voffB); PG8_STAGE(PG8_SA(0, 0), a2, voffA);
            PG8_WAIT_V(8); PG8_WAIT_L(0); PG8_BAR; PG8_MMA(1, 0, At, B0); PG8_MMA(1, 1, At, B1); PG8_BAR; PG8_SCHED;
            PG8_LDB(B0, 1, 0); PG8_LDB(B1, 1, 1); PG8_SCHED; PG8_LDA(At, 1, 0); PG8_STAGE(PG8_SA(0, 1), a2 + hstep, voffA);
            PG8_WAIT_V(8); PG8_WAIT_L(0); PG8_BAR; PG8_MMA(0, 0, At, B0); PG8_MMA(0, 1, At, B1); PG8_BAR; PG8_SCHED;
            PG8_LDA(At, 1, 1); PG8_STAGE(PG8_SB(1, 0), b3, voffB); PG8_STAGE(PG8_SB(1, 1), b3 + hstep, voffB); PG8_STAGE(PG8_SA(1, 0), a3, voffA);
            PG8_WAIT_V(8); PG8_WAIT_L(0); PG8_BAR; PG8_MMA(1, 0, At, B0); PG8_MMA(1, 1, At, B1); PG8_BAR; PG8_SCHED;
            } else {
            PG8_LDB(B0, 0, 0); PG8_SCHED; PG8_LDA(At, 0, 0); PG8_STAGE(PG8_SA(1, 1), a1 + hstep, voffA);
            PG8_WAIT_L(8); PG8_BAR; PG8_WAIT_L(0); PG8_MMA(0, 0, At, B0); PG8_BAR; PG8_SCHED;
            PG8_LDB(B1, 0, 1); PG8_STAGE(PG8_SB(0, 0), b2, voffB);
            PG8_BAR; PG8_WAIT_L(0); PG8_MMA(0, 1, At, B1); PG8_BAR;
            PG8_LDA(At, 0, 1); PG8_STAGE(PG8_SA(0, 0), a2, voffA);
            PG8_BAR; PG8_WAIT_L(0); PG8_MMA(1, 0, At, B0); PG8_BAR; PG8_SCHED;
            PG8_STAGE(PG8_SB(0, 1), b2 + hstep, voffB);
            PG8_WAIT_V(6); PG8_BAR; PG8_MMA(1, 1, At, B1); PG8_BAR;
            PG8_LDB(B0, 1, 0); PG8_SCHED; PG8_LDA(At, 1, 0); PG8_STAGE(PG8_SA(0, 1), a2 + hstep, voffA);
            PG8_WAIT_L(8); PG8_BAR; PG8_WAIT_L(0); PG8_MMA(0, 0, At, B0); PG8_BAR; PG8_SCHED;
            PG8_LDB(B1, 1, 1); PG8_STAGE(PG8_SB(1, 0), b3, voffB);
            PG8_BAR; PG8_WAIT_L(0); PG8_MMA(0, 1, At, B1); PG8_BAR;
            PG8_LDA(At, 1, 1); PG8_STAGE(PG8_SA(1, 0), a3, voffA);
            PG8_BAR; PG8_WAIT_L(0); PG8_MMA(1, 0, At, B0); PG8_BAR; PG8_SCHED;
            PG8_STAGE(PG8_SB(1, 1), b3 + hstep, voffB);
            PG8_WAIT_V(6); PG8_BAR; PG8_MMA(1, 1, At, B1); PG8_BAR;
            }
        }
        if constexpr (ALIGN_EPI) { if (wr == 0) PG8_BAR; }
        if constexpr (!Epi::AFTER_DRAIN) { PG8_EPI_DRAIN(); E(acc, cur, wr, wc, fr, fq); PG8_EPI_DRAIN(); S.done(cur); }
        if (!has_next) break;
#pragma unroll
        for (int a = 0; a < 2; ++a)
#pragma unroll
            for (int b = 0; b < 2; ++b)
#pragma unroll
                for (int m = 0; m < 4; ++m)
#pragma unroll
                    for (int n = 0; n < 2; ++n) acc[a][b][m][n] = (f32x4){0.f, 0.f, 0.f, 0.f};
        cur = nxt; cA = nA; cB = nB; ++ui;
        if constexpr (ALIGN_EPI) { if (wr == 1) PG8_BAR; }
    }
    PG8_WAIT_V(0);
    if constexpr (!ALIGN_EPI) { if (wr == 0) PG8_BAR; }
    PG8_BAR;
    if constexpr (Epi::AFTER_DRAIN) { E.fused(acc, cur, wr, wc, fr, fq, lds, wid, lane); S.done(cur); }
#undef PG8_SA
#undef PG8_SB
#undef PG8_STAGE
#undef PG8_LDA
#undef PG8_LDB
#undef PG8_MMA
#undef PG8_WAIT_V
#undef PG8_WAIT_L
#undef PG8_BAR
#undef PG8_SCHED
}
}

#define LAS __attribute__((address_space(3)))
typedef unsigned short bf16_t;
typedef short bf16x8 __attribute__((ext_vector_type(8)));
typedef float f32x4 __attribute__((ext_vector_type(4)));
typedef float f32x16 __attribute__((ext_vector_type(16)));
typedef unsigned u32x4 __attribute__((ext_vector_type(4)));
typedef unsigned u32x2 __attribute__((ext_vector_type(2)));
typedef short v4i16_t __attribute__((ext_vector_type(4)));

constexpr int NTOK = 16384, DM = 1024, DFF = 2816, DIN = 5120, SEQ = 4096;
constexpr size_t MiB = (size_t)1 << 20;
constexpr size_t WS_SSQ = 0;
constexpr size_t WS_WGU1 = 1 * MiB, WS_WD1 = 12 * MiB, WS_WIN = WS_WD1 + 11 * MiB / 2, WS_WA = WS_WIN + 10 * MiB, WS_WB = WS_WA + 1 * MiB, WS_WOUT = WS_WB + 1 * MiB,
                 WS_WGU2 = WS_WOUT + 2 * MiB, WS_WD2 = WS_WGU2 + 11 * MiB;
constexpr size_t WS_XB = 48 * MiB;
constexpr size_t WS_BIG = 80 * MiB;
constexpr size_t WS_GATES = 176 * MiB;
constexpr size_t WS_Y = WS_BIG + 16 * MiB;
constexpr size_t WS_SSQP = 240 * MiB;
constexpr size_t SSQ_STRIDE = (size_t)NTOK * 16;
constexpr size_t WS_WAB = 244 * MiB;
constexpr size_t WS_END = 248 * MiB;
static_assert(WS_WD2 + 11 * MiB / 2 == 48 * MiB, "weight map");
constexpr size_t QKV_ELEMS = (size_t)NTOK * 512;
constexpr int LDS_BYTES = 147456;

__device__ __forceinline__ float wave_sum(float v) {
#pragma unroll
    for (int o = 1; o < 64; o <<= 1) v += __shfl_xor(v, o);
    return v;
}
__device__ __forceinline__ unsigned cvtpk(float lo, float hi) { unsigned r; asm volatile("v_cvt_pk_bf16_f32 %0, %1, %2" : "=v"(r) : "v"(lo), "v"(hi)); return r; }

struct PItem { const float* W; const float* gain; bf16_t* WT; int N, pitch, drow, kdst, zoff, k0, n0; };
struct Args { const float* in[21]; float* out; unsigned char* ws; };
__device__ __forceinline__ PItem p0_decode(const Args& a, int it) {
    unsigned char* ws = a.ws;
    constexpr int C_UP = (DM / 64) * (DFF / 32), C_DN = (DFF / 64) * (DM / 32), C_IN = (DM / 64) * (DIN / 32), C_BR = (512 / 64) * (DM / 32), C_OUT = (DM / 64) * (DM / 32);
    constexpr int E0 = C_UP, E1 = E0 + C_UP, E2 = E1 + C_DN, E3 = E2 + C_IN, E4 = E3 + C_BR, E5 = E4 + C_BR, E6 = E5 + C_OUT, E7 = E6 + C_UP, E8 = E7 + C_UP;
    int r = it, mi = 0;
    if (it >= E8) { mi = 9; r = it - E8; } else if (it >= E7) { mi = 8; r = it - E7; } else if (it >= E6) { mi = 7; r = it - E6; } else if (it >= E5) { mi = 6; r = it - E5; }
    else if (it >= E4) { mi = 5; r = it - E4; } else if (it >= E3) { mi = 4; r = it - E3; } else if (it >= E2) { mi = 3; r = it - E2; } else if (it >= E1) { mi = 2; r = it - E1; }
    else if (it >= E0) { mi = 1; r = it - E0; }
    const float* W = a.in[2]; const float* gp = nullptr; int K = DM, N = DFF, mode = 0; size_t doff = WS_WGU1;
    switch (mi) {
        case 0: W = a.in[2]; gp = a.in[1]; K = DM; N = DFF;  mode = 1; doff = WS_WGU1; break;
        case 1: W = a.in[3]; gp = a.in[1]; K = DM; N = DFF;  mode = 2; doff = WS_WGU1; break;
        case 2: W = a.in[4]; gp = nullptr; K = DFF; N = DM; mode = 0; doff = WS_WD1;  break;
        case 3: W = a.in[6]; gp = a.in[5]; K = DM; N = DIN;  mode = 0; doff = WS_WIN;  break;
        case 4: W = a.in[13]; gp = nullptr; K = 512; N = DM; mode = 3; doff = WS_WAB;  break;
        case 5: W = a.in[14]; gp = nullptr; K = 512; N = DM; mode = 4; doff = WS_WAB;  break;
        case 6: W = a.in[15]; gp = nullptr; K = DM; N = DM; mode = 0; doff = WS_WOUT; break;
        case 7: W = a.in[17]; gp = a.in[16]; K = DM; N = DFF; mode = 1; doff = WS_WGU2; break;
        case 8: W = a.in[18]; gp = a.in[16]; K = DM; N = DFF; mode = 2; doff = WS_WGU2; break;
        default: W = a.in[19]; gp = nullptr; K = DFF; N = DM; mode = 0; doff = WS_WD2;  break;
    }
    const int nblk = N / 32, kb = r / nblk, nb = r % nblk, k0 = 64 * kb, n0 = 32 * nb;
    PItem p; p.W = W; p.gain = gp; p.WT = (bf16_t*)(ws + doff); p.N = N; p.pitch = K; p.k0 = k0; p.n0 = n0; p.kdst = k0; p.zoff = -1;
    int drow = n0; if (mi == 3) drow = (n0 >= 3072) ? n0 - 3072 : n0 + 2048;
    if (mode == 1 || mode == 2) drow = (n0 >> 7) * 256 + (n0 & 127) + (mode == 2 ? 128 : 0);
    if (mode >= 3) {
        drow = (n0 >> 7) * 256 + (n0 & 127) + (mode == 4 ? 128 : 0); p.pitch = 1024; p.kdst = k0 + (mode == 4 ? 512 : 0); p.zoff = k0 + (mode == 4 ? 0 : 512); }
    p.drow = drow;
    return p;
}
__device__ __forceinline__ void p0_load(const PItem& p, float (&w)[32], int lane) {
#pragma unroll
    for (int i = 0; i < 32; ++i) { const int kk = 2 * i + (lane >> 5); w[i] = p.W[(size_t)(p.k0 + kk) * p.N + p.n0 + (lane & 31)]; }
}
__device__ __forceinline__ void p0_store(const PItem& p, const float (&w)[32], LAS float* scr, int lane) {
#pragma unroll
    for (int i = 0; i < 32; ++i) scr[(2 * i + (lane >> 5)) * 33 + (lane & 31)] = w[i];
    asm volatile("s_waitcnt lgkmcnt(0)" ::: "memory");
    const int c = lane & 7;
    f32x4 g0 = (f32x4){1.f, 1.f, 1.f, 1.f}, g1 = g0;
    if (p.gain) { g0 = *(const f32x4*)(p.gain + p.k0 + 8 * c); g1 = *(const f32x4*)(p.gain + p.k0 + 8 * c + 4); }
#pragma unroll
    for (int j = 0; j < 4; ++j) { const int n = (lane >> 3) + 8 * j; const LAS float* s = scr + (8 * c) * 33 + n;
        u32x4 o; o.x = cvtpk(s[0 * 33] * g0[0], s[1 * 33] * g0[1]); o.y = cvtpk(s[2 * 33] * g0[2], s[3 * 33] * g0[3]); o.z = cvtpk(s[4 * 33] * g1[0], s[5 * 33] * g1[1]); o.w = cvtpk(s[6 * 33] * g1[2], s[7 * 33] * g1[3]);
        bf16_t* row = p.WT + (size_t)(p.drow + n) * p.pitch;
        *(u32x4*)(row + p.kdst + 8 * c) = o;
        if (p.zoff >= 0) *(u32x4*)(row + p.zoff + 8 * c) = (u32x4){0u, 0u, 0u, 0u}; }
    asm volatile("s_waitcnt lgkmcnt(0)" ::: "memory");
}
__device__ __forceinline__ void prologue_items(const Args& a, LAS unsigned char* lds, int lo, int hi, int gw, int NGW, int wave, int lane) {
    LAS float* scr = (LAS float*)(lds + wave * 16384);
    for (int it = lo + gw; it < hi; it += 2 * NGW) {
        const bool has1 = (it + NGW < hi);
        const PItem p0 = p0_decode(a, it), p1 = p0_decode(a, has1 ? it + NGW : it);
        float w0[32], w1[32];
        p0_load(p0, w0, lane); if (has1) p0_load(p1, w1, lane);
        p0_store(p0, w0, scr, lane); if (has1) p0_store(p1, w1, scr, lane);
    }
}
constexpr int PI_E1 = 2 * (DM / 64) * (DFF / 32), PI_E3 = 6 * (DM / 64) * (DFF / 32) + (DM / 64) * (DIN / 32) + 2 * (512 / 64) * (DM / 32) + (DM / 64) * (DM / 32) - (DFF / 64) * (DM / 32);
constexpr int PI_TOTAL = 6 * (DM / 64) * (DFF / 32) + (DM / 64) * (DIN / 32) + 2 * (512 / 64) * (DM / 32) + (DM / 64) * (DM / 32), PI_E8 = PI_TOTAL - (DFF / 64) * (DM / 32);
__device__ __forceinline__ void prologue(const Args& a, LAS unsigned char* lds, int gw, int NGW, int wave, int lane) {
    unsigned char* ws = a.ws;
    prologue_items(a, lds, 0, PI_E1, gw, NGW, wave, lane);
    prologue_items(a, lds, PI_E3, PI_E8, gw, NGW, wave, lane);
    float* ssq = (float*)(ws + WS_SSQP); bf16_t* xb = (bf16_t*)(ws + WS_XB);
    for (int m = gw; m < NTOK; m += 2 * NGW) {
        const int m1 = m + NGW;
        const f32x4* xr0 = (const f32x4*)(a.in[0] + (size_t)m * DM) + lane; const f32x4* xr1 = (const f32x4*)(a.in[0] + (size_t)m1 * DM) + lane;
        f32x4 v0[4], v1[4];
#pragma unroll
        for (int j = 0; j < 4; ++j) { v0[j] = xr0[64 * j]; v1[j] = xr1[64 * j]; }
        float s0 = 0.f, s1 = 0.f;
        unsigned long long* o0 = (unsigned long long*)(xb + (size_t)m * DM) + lane; unsigned long long* o1 = (unsigned long long*)(xb + (size_t)m1 * DM) + lane;
#pragma unroll
        for (int j = 0; j < 4; ++j) {
            s0 += (v0[j][0] * v0[j][0] + v0[j][1] * v0[j][1]) + (v0[j][2] * v0[j][2] + v0[j][3] * v0[j][3]);
            s1 += (v1[j][0] * v1[j][0] + v1[j][1] * v1[j][1]) + (v1[j][2] * v1[j][2] + v1[j][3] * v1[j][3]);
            o0[64 * j] = (unsigned long long)cvtpk(v0[j][0], v0[j][1]) | ((unsigned long long)cvtpk(v0[j][2], v0[j][3]) << 32);
            o1[64 * j] = (unsigned long long)cvtpk(v1[j][0], v1[j][1]) | ((unsigned long long)cvtpk(v1[j][2], v1[j][3]) << 32); }
        s0 = wave_sum(s0); s1 = wave_sum(s1);
        if (lane < 16) { ssq[(size_t)m * 16 + lane] = (lane == 0) ? s0 : 0.f; ssq[(size_t)m1 * 16 + lane] = (lane == 0) ? s1 : 0.f; }
    }
}

__device__ __forceinline__ void final_norm(const Args& a, int G, int bx, int wave, int lane) {
    const float* ssq = (const float*)(a.ws + WS_SSQP) + 3 * SSQ_STRIDE; const bf16_t* hb = (const bf16_t*)(a.ws + WS_XB);
    f32x4 gv[4];
#pragma unroll
    for (int j = 0; j < 2; ++j) { gv[2 * j] = *(const f32x4*)(a.in[20] + 512 * j + 8 * lane); gv[2 * j + 1] = *(const f32x4*)(a.in[20] + 512 * j + 8 * lane + 4); }
    pg8::StaticOrder S; S.init(NTOK, DM, G, bx); pg8::Unit u;
    for (int i = 0; S.next(i, u); ++i) {
        const int m0 = u.pm * 256 + u.pn * 64 + wave * 8;
        float sp[8]; u32x4 pv[8][2];
#pragma unroll
        for (int rr = 0; rr < 8; ++rr) { sp[rr] = (lane < 16) ? ssq[(size_t)(m0 + rr) * 16 + lane] : 0.f;
#pragma unroll
            for (int j = 0; j < 2; ++j) pv[rr][j] = *(const u32x4*)(hb + (size_t)(m0 + rr) * DM + 512 * j + 8 * lane); }
#pragma unroll
        for (int rr = 0; rr < 8; ++rr) {
            const int m = m0 + rr;
            const float r = __builtin_amdgcn_rsqf(wave_sum(sp[rr]) * (1.0f / 1024.0f) + 1e-5f);
#pragma unroll
            for (int j = 0; j < 2; ++j) { const u32x4 p = pv[rr][j];
                const f32x4 v0 = (f32x4){__builtin_bit_cast(float, p.x << 16), __builtin_bit_cast(float, p.x & 0xffff0000u), __builtin_bit_cast(float, p.y << 16), __builtin_bit_cast(float, p.y & 0xffff0000u)};
                const f32x4 v1 = (f32x4){__builtin_bit_cast(float, p.z << 16), __builtin_bit_cast(float, p.z & 0xffff0000u), __builtin_bit_cast(float, p.w << 16), __builtin_bit_cast(float, p.w & 0xffff0000u)};
                float* o = a.out + (size_t)m * DM + 512 * j + 8 * lane;
                *(f32x4*)o = v0 * r * gv[2 * j]; *(f32x4*)(o + 4) = v1 * r * gv[2 * j + 1]; }
        }
    }
}

namespace att {
constexpr int KVS = 320;
#ifndef KSTR
#define KSTR 288
#endif
constexpr int KS = KSTR;
constexpr int TILE_B = 64 * KVS;
constexpr int OFF_SCR = 6 * TILE_B;
constexpr int OFF_FLAG = OFF_SCR + 2048;
constexpr int OSTR = 129;
constexpr float C2_DA = 0.125f * 1.4426950408889634f;
constexpr float C2_SB = 0.08838834764831845f * 1.4426950408889634f;
#ifndef SB_EARLY_EXIT
#define SB_EARLY_EXIT 1
#endif
constexpr float SB_RTHR = 64.0f;

__device__ __forceinline__ int crow(int r, int hi) { return (r & 3) + 8 * (r >> 2) + 4 * hi; }
__device__ __forceinline__ v4i16_t vtr(LAS const unsigned char* p) { return __builtin_amdgcn_ds_read_tr16_b64_v4i16((LAS v4i16_t*)p); }

__device__ __forceinline__ void stage_load(u32x4 (&st)[4], const bf16_t* Kg, const bf16_t* Vg, int key0, int tid) {
#pragma unroll
    for (int i = 0; i < 2; ++i) { const int c = tid + 512 * i, row = c >> 4, cc = c & 15; const size_t off = (size_t)(key0 + row) * 512 + 8 * cc;
        st[i] = *(const u32x4*)(Kg + off); st[2 + i] = *(const u32x4*)(Vg + off); }
}
__device__ __forceinline__ void stage_store(LAS unsigned char* lds, int buf, const u32x4 (&st)[4], int tid) {
#pragma unroll
    for (int i = 0; i < 2; ++i) { const int c = tid + 512 * i, row = c >> 4, cc = c & 15; LAS unsigned char* pk = lds + buf * 2 * TILE_B + row * KS + cc * 16; LAS unsigned char* pv = lds + buf * 2 * TILE_B + TILE_B + row * KVS + cc * 16;
        *(LAS u32x4*)pk = st[i]; *(LAS u32x4*)pv = st[2 + i]; }
}
__device__ __forceinline__ void pv_tile(f32x16 (&o)[4], const u32x4 (&pk)[4], LAS const unsigned char* Vb, int lane) {
    const int hi = lane >> 5;
    LAS const unsigned char* vp = Vb + (4 * hi + ((lane & 15) >> 2)) * KVS + (((lane >> 4) & 1) * 16 + (lane & 3) * 4) * 2;
#pragma unroll
    for (int db = 0; db < 4; ++db)
#pragma unroll
        for (int ks = 0; ks < 4; ++ks) {
            const v4i16_t lo = vtr(vp + (16 * ks) * KVS + db * 64), hh = vtr(vp + (16 * ks + 8) * KVS + db * 64);
            const bf16x8 vb = (bf16x8){lo[0], lo[1], lo[2], lo[3], hh[0], hh[1], hh[2], hh[3]};
            o[db] = __builtin_amdgcn_mfma_f32_32x32x16_bf16(__builtin_bit_cast(bf16x8, pk[ks]), vb, o[db], 0, 0, 0);
        }
}

__device__ __forceinline__ void diff_unit(LAS unsigned char* lds, const bf16_t* Q, const bf16_t* K, const bf16_t* V, bf16_t* A, int b, int h, int qb, float lam, const float* subln) {
    int tid_ = threadIdx.x; asm volatile("" : "+v"(tid_));
    const int tid = tid_, lane = tid & 63, r32 = lane & 31, hi = lane >> 5; const int wid = __builtin_amdgcn_readfirstlane(tid >> 6);
    const int g = wid >> 1, m = wid & 1;
    const size_t rowbase = (size_t)b * SEQ; const int q0 = qb * 128;
    const float sl2 = __builtin_amdgcn_exp2f(-2.0f * (float)(h + 1)) * 1.4426950408889634f;
    const bf16_t* Kg = K + rowbase * 512 + 128 * h; const bf16_t* Vg = V + rowbase * 512 + 128 * h;
    const int NT = (q0 + 128) / 64;
    u32x4 st[4];
    stage_load(st, Kg, Vg, (NT - 1) * 64, tid);
    bf16x8 qf[4];
    { const bf16_t* Qw = Q + (rowbase + q0 + 32 * g + r32) * 512 + 128 * h + 64 * m + 8 * hi;
#pragma unroll
      for (int d0 = 0; d0 < 4; ++d0) qf[d0] = *(const bf16x8*)(Qw + 16 * d0); }
    stage_store(lds, 0, st, tid);
    __syncthreads();
    LAS float* scr = (LAS float*)(lds + OFF_SCR) + wid * 64;
    const int qmin = q0 + 32 * g, qmax = qmin + 31, qpos = qmin + r32;
    float mref = -1e30f, lsum = 0.f;
    f32x16 o[4];
#pragma unroll
    for (int i = 0; i < 4; ++i)
#pragma unroll
        for (int r = 0; r < 16; ++r) o[i][r] = 0.f;
    const float bhi = sl2 * (float)(4 * hi);
    u32x4 pkp[4]; bool have_prev = false; int prev_off = 0, buf = 0;
#pragma unroll
    for (int i = 0; i < 4; ++i) pkp[i] = (u32x4){0u, 0u, 0u, 0u};
    for (int it = 0; it < NT; ++it) {
        const int jt = NT - 1 - it, key0 = jt * 64, nbuf = (buf == 2) ? 0 : buf + 1;
        if (it + 1 < NT) stage_load(st, Kg, Vg, (jt - 1) * 64, tid);
        const bool active = (key0 <= qmax);
        LAS const unsigned char* Kb = lds + buf * 2 * TILE_B;
        f32x16 p0, p1;
#pragma unroll
        for (int r = 0; r < 16; ++r) { p0[r] = 0.f; p1[r] = 0.f; }
        if (active) {
#pragma unroll
            for (int d0 = 0; d0 < 4; ++d0) {
                const bf16x8 k0 = *(LAS const bf16x8*)(Kb + r32 * KS + (64 * m + 16 * d0 + 8 * hi) * 2);
                const bf16x8 k1 = *(LAS const bf16x8*)(Kb + (32 + r32) * KS + (64 * m + 16 * d0 + 8 * hi) * 2);
                p0 = __builtin_amdgcn_mfma_f32_32x32x16_bf16(k0, qf[d0], p0, 0, 0, 0);
                p1 = __builtin_amdgcn_mfma_f32_32x32x16_bf16(k1, qf[d0], p1, 0, 0, 0);
            }
        }
        if (have_prev) pv_tile(o, pkp, lds + prev_off + TILE_B, lane);
        if (active) {
            const float shift = sl2 * (float)(key0 - q0) + bhi;
            const bool needmask = (key0 + 63 > qmin); const int kk0 = key0 + 4 * hi;
            float rm = -INFINITY;
#pragma unroll
            for (int r = 0; r < 16; ++r) {
                const int kv = (r & 3) + 8 * (r >> 2);
                float s0 = __builtin_fmaf(sl2, (float)kv, p0[r]), s1 = __builtin_fmaf(sl2, (float)(kv + 32), p1[r]);
                if (needmask) { if (kk0 + kv > qpos) s0 = -INFINITY; if (kk0 + kv + 32 > qpos) s1 = -INFINITY; }
                p0[r] = s0; p1[r] = s1; rm = fmaxf(rm, fmaxf(s0, s1));
            }
            rm += shift; rm = fmaxf(rm, __shfl_xor(rm, 32));
            if (__any(rm > mref + 8.0f)) {
                const float mnew = fmaxf(mref, rm); const float f = __builtin_amdgcn_exp2f(mref - mnew);
                lsum *= f; mref = mnew;
                if (hi == 0) scr[r32] = f;
                __builtin_amdgcn_wave_barrier();
#pragma unroll
                for (int r = 0; r < 16; ++r) { const float fr_ = scr[crow(r, hi)];
#pragma unroll
                    for (int db = 0; db < 4; ++db) o[db][r] *= fr_; }
                __builtin_amdgcn_wave_barrier();
            }
            const float msh = mref - shift; float ls = 0.f;
#pragma unroll
            for (int r = 0; r < 16; ++r) { p0[r] = __builtin_amdgcn_exp2f(p0[r] - msh); p1[r] = __builtin_amdgcn_exp2f(p1[r] - msh); ls += p0[r] + p1[r]; }
            lsum += ls;
            pkp[0] = (u32x4){cvtpk(p0[0], p0[1]), cvtpk(p0[2], p0[3]), cvtpk(p0[4], p0[5]), cvtpk(p0[6], p0[7])};
            pkp[1] = (u32x4){cvtpk(p0[8], p0[9]), cvtpk(p0[10], p0[11]), cvtpk(p0[12], p0[13]), cvtpk(p0[14], p0[15])};
            pkp[2] = (u32x4){cvtpk(p1[0], p1[1]), cvtpk(p1[2], p1[3]), cvtpk(p1[4], p1[5]), cvtpk(p1[6], p1[7])};
            pkp[3] = (u32x4){cvtpk(p1[8], p1[9]), cvtpk(p1[10], p1[11]), cvtpk(p1[12], p1[13]), cvtpk(p1[14], p1[15])};
            have_prev = true; prev_off = buf * 2 * TILE_B;
        }
        if (it + 1 < NT) stage_store(lds, nbuf, st, tid);
        buf = nbuf;
        __syncthreads();
    }
    if (have_prev) pv_tile(o, pkp, lds + prev_off + TILE_B, lane);
    __syncthreads();
    lsum += __shfl_xor(lsum, 32);
    if (hi == 0) scr[r32] = lsum;
    __builtin_amdgcn_wave_barrier();
    LAS float* Ob = (LAS float*)lds;
    const float fac = (m == 0) ? 1.0f : -lam;
    float rl[16];
#pragma unroll
    for (int r = 0; r < 16; ++r) rl[r] = fac / scr[crow(r, hi)];
    if (m == 1) {
#pragma unroll
        for (int r = 0; r < 16; ++r)
#pragma unroll
            for (int db = 0; db < 4; ++db) Ob[(32 * g + crow(r, hi)) * OSTR + 32 * db + r32] = o[db][r] * rl[r];
    }
    __syncthreads();
    if (m == 0) {
#pragma unroll
        for (int r = 0; r < 16; ++r)
#pragma unroll
            for (int db = 0; db < 4; ++db) { LAS float* p = Ob + (32 * g + crow(r, hi)) * OSTR + 32 * db + r32; *p = *p + o[db][r] * rl[r]; }
    }
    __syncthreads();
    {
        const int row = tid >> 2, part = tid & 3; const LAS float* src = Ob + row * OSTR + 32 * part;
        float v[32]; float ss = 0.f;
#pragma unroll
        for (int i = 0; i < 32; ++i) { v[i] = src[i]; ss += v[i] * v[i]; }
        ss += __shfl_xor(ss, 1); ss += __shfl_xor(ss, 2);
        const float rs = 0.8f / sqrtf(ss * (1.0f / 128.0f) + 1e-5f);
        const f32x4* gp = (const f32x4*)(subln + 32 * part);
        bf16_t* dst = A + (rowbase + q0 + row) * 1024 + 128 * h + 32 * part;
#pragma unroll
        for (int c = 0; c < 4; ++c) {
            const f32x4 g0 = gp[2 * c], g1 = gp[2 * c + 1];
            u32x4 w;
            w.x = cvtpk(v[8 * c + 0] * rs * g0[0], v[8 * c + 1] * rs * g0[1]); w.y = cvtpk(v[8 * c + 2] * rs * g0[2], v[8 * c + 3] * rs * g0[3]);
            w.z = cvtpk(v[8 * c + 4] * rs * g1[0], v[8 * c + 5] * rs * g1[1]); w.w = cvtpk(v[8 * c + 6] * rs * g1[2], v[8 * c + 7] * rs * g1[3]);
            *(u32x4*)(dst + 8 * c) = w;
        }
    }
    __syncthreads();
}

__device__ __forceinline__ void sb_unit(LAS unsigned char* lds, const bf16_t* Q, const bf16_t* K, const bf16_t* V, bf16_t* Bo, int b, int h, int qb) {
    int tid_ = threadIdx.x; asm volatile("" : "+v"(tid_));
    const int tid = tid_, lane = tid & 63, r32 = lane & 31, hi = lane >> 5; const int wid = __builtin_amdgcn_readfirstlane(tid >> 6);
    const size_t rowbase = (size_t)b * SEQ; const int q0 = qb * 256;
    const bf16_t* Kg = K + rowbase * 512 + 128 * h; const bf16_t* Vg = V + rowbase * 512 + 128 * h;
    const int NT = (q0 + 256) / 64;
    u32x4 st[4];
    stage_load(st, Kg, Vg, (NT - 1) * 64, tid);
    const int qmin = q0 + 32 * wid, qmax = qmin + 31, qpos = qmin + r32;
    bf16x8 qf[8];
    { const bf16_t* Qw = Q + (rowbase + qpos) * 512 + 128 * h + 8 * hi;
#pragma unroll
      for (int d0 = 0; d0 < 8; ++d0) qf[d0] = *(const bf16x8*)(Qw + 16 * d0); }
    bf16x8 tt0, tt1, ones;
#pragma unroll
    for (int j = 0; j < 8; ++j) { const int kin = (j & 3) + 8 * (j >> 2) + 4 * hi;
        tt0[j] = (kin >= r32) ? (short)0x3F80 : (short)0; tt1[j] = (16 + kin >= r32) ? (short)0x3F80 : (short)0; ones[j] = (short)0x3F80; }
    stage_store(lds, 0, st, tid);
    __syncthreads();
    volatile LAS unsigned* flags = (volatile LAS unsigned*)(lds + OFF_FLAG);
    float R = 0.f; bool wave_done = false;
    f32x16 o[4];
#pragma unroll
    for (int i = 0; i < 4; ++i)
#pragma unroll
        for (int r = 0; r < 16; ++r) o[i][r] = 0.f;
    for (int it = 0; it < NT; ++it) {
        const int jt = NT - 1 - it, buf = it & 1, key0 = jt * 64;
        if (it + 1 < NT) stage_load(st, Kg, Vg, (jt - 1) * 64, tid);
        if (key0 < qmax && !wave_done) {
            LAS const unsigned char* Kb = lds + buf * 2 * TILE_B; LAS const unsigned char* Vb = Kb + TILE_B;
            f32x16 p0, p1;
#pragma unroll
            for (int r = 0; r < 16; ++r) { p0[r] = 0.f; p1[r] = 0.f; }
#pragma unroll
            for (int d0 = 0; d0 < 8; ++d0) {
                const bf16x8 k0 = *(LAS const bf16x8*)(Kb + r32 * KS + (16 * d0 + 8 * hi) * 2);
                const bf16x8 k1 = *(LAS const bf16x8*)(Kb + (32 + r32) * KS + (16 * d0 + 8 * hi) * 2);
                p0 = __builtin_amdgcn_mfma_f32_32x32x16_bf16(k0, qf[d0], p0, 0, 0, 0);
                p1 = __builtin_amdgcn_mfma_f32_32x32x16_bf16(k1, qf[d0], p1, 0, 0, 0);
            }
            const bool needmask = (key0 + 63 >= qmin); const int kk0 = key0 + 4 * hi;
            f32x16 u0, u1;
#pragma unroll
            for (int r = 0; r < 16; ++r) {
                const int kv = (r & 3) + 8 * (r >> 2);
                float a0 = __builtin_amdgcn_logf(1.0f + __builtin_amdgcn_exp2f(p0[r])), a1 = __builtin_amdgcn_logf(1.0f + __builtin_amdgcn_exp2f(p1[r]));
                a0 = (p0[r] > 30.f) ? p0[r] : a0; a1 = (p1[r] > 30.f) ? p1[r] : a1;
                if (needmask) { if (kk0 + kv >= qpos) a0 = 0.f; if (kk0 + kv + 32 >= qpos) a1 = 0.f; }
                u0[r] = a0; u1[r] = a1;
            }
            u32x4 uk[4];
            uk[0] = (u32x4){cvtpk(u0[0], u0[1]), cvtpk(u0[2], u0[3]), cvtpk(u0[4], u0[5]), cvtpk(u0[6], u0[7])};
            uk[1] = (u32x4){cvtpk(u0[8], u0[9]), cvtpk(u0[10], u0[11]), cvtpk(u0[12], u0[13]), cvtpk(u0[14], u0[15])};
            uk[2] = (u32x4){cvtpk(u1[0], u1[1]), cvtpk(u1[2], u1[3]), cvtpk(u1[4], u1[5]), cvtpk(u1[6], u1[7])};
            uk[3] = (u32x4){cvtpk(u1[8], u1[9]), cvtpk(u1[10], u1[11]), cvtpk(u1[12], u1[13]), cvtpk(u1[14], u1[15])};
            f32x16 c0, c1;
#pragma unroll
            for (int r = 0; r < 16; ++r) { c0[r] = R; c1[r] = R; }
            c0 = __builtin_amdgcn_mfma_f32_32x32x16_bf16(tt0, __builtin_bit_cast(bf16x8, uk[0]), c0, 0, 0, 0);
            c0 = __builtin_amdgcn_mfma_f32_32x32x16_bf16(tt1, __builtin_bit_cast(bf16x8, uk[1]), c0, 0, 0, 0);
            c0 = __builtin_amdgcn_mfma_f32_32x32x16_bf16(ones, __builtin_bit_cast(bf16x8, uk[2]), c0, 0, 0, 0);
            c0 = __builtin_amdgcn_mfma_f32_32x32x16_bf16(ones, __builtin_bit_cast(bf16x8, uk[3]), c0, 0, 0, 0);
            c1 = __builtin_amdgcn_mfma_f32_32x32x16_bf16(tt0, __builtin_bit_cast(bf16x8, uk[2]), c1, 0, 0, 0);
            c1 = __builtin_amdgcn_mfma_f32_32x32x16_bf16(tt1, __builtin_bit_cast(bf16x8, uk[3]), c1, 0, 0, 0);
#pragma unroll
            for (int r = 0; r < 16; ++r) {
                const int kv = (r & 3) + 8 * (r >> 2);
                float a0 = __builtin_amdgcn_exp2f(p0[r] - c0[r]), a1 = __builtin_amdgcn_exp2f(p1[r] - c1[r]);
                if (needmask) { if (kk0 + kv >= qpos) a0 = 0.f; if (kk0 + kv + 32 >= qpos) a1 = 0.f; }
                p0[r] = a0; p1[r] = a1;
            }
            R = __shfl(c0[0], r32);
            u32x4 pk[4];
            pk[0] = (u32x4){cvtpk(p0[0], p0[1]), cvtpk(p0[2], p0[3]), cvtpk(p0[4], p0[5]), cvtpk(p0[6], p0[7])};
            pk[1] = (u32x4){cvtpk(p0[8], p0[9]), cvtpk(p0[10], p0[11]), cvtpk(p0[12], p0[13]), cvtpk(p0[14], p0[15])};
            pk[2] = (u32x4){cvtpk(p1[0], p1[1]), cvtpk(p1[2], p1[3]), cvtpk(p1[4], p1[5]), cvtpk(p1[6], p1[7])};
            pk[3] = (u32x4){cvtpk(p1[8], p1[9]), cvtpk(p1[10], p1[11]), cvtpk(p1[12], p1[13]), cvtpk(p1[14], p1[15])};
            pv_tile(o, pk, Vb, lane);
#if SB_EARLY_EXIT
            wave_done = __all(R > SB_RTHR);
#endif
        }
        if (it + 1 < NT) stage_store(lds, buf ^ 1, st, tid);
#if SB_EARLY_EXIT
        if (lane == 0) flags[buf * 8 + wid] = wave_done ? 1u : 0u;
#endif
        __syncthreads();
#if SB_EARLY_EXIT
        { unsigned all = 1u;
#pragma unroll
          for (int w = 0; w < 8; ++w) all &= flags[buf * 8 + w];
          if (all) break; }
#endif
    }
    { LAS unsigned short* stg = (LAS unsigned short*)(lds + wid * (32 * 272));
#pragma unroll
      for (int r = 0; r < 16; ++r)
#pragma unroll
          for (int db = 0; db < 4; ++db) stg[crow(r, hi) * 136 + 32 * db + r32] = (unsigned short)(cvtpk(o[db][r], 0.f) & 0xffffu);
      __builtin_amdgcn_wave_barrier();
      bf16_t* dst = Bo + (rowbase + qmin) * 1024 + 128 * h;
#pragma unroll
      for (int i = 0; i < 8; ++i) { const int row = i * 4 + (lane >> 4), ch = lane & 15;
          const u32x4 v = *(const LAS u32x4*)(lds + wid * (32 * 272) + row * 272 + ch * 16);
          *(u32x4*)(dst + (size_t)row * 1024 + ch * 8) = v; }
    }
    __syncthreads();
}
}

#ifndef PH
#define PH 0xFFF
#endif
#ifndef REP
#define REP 0
#endif
#define NREP(bit) ((REP & (bit)) ? 2 : 1)
#ifndef GRID_SYNC

#endif
__device__ __forceinline__ void grid_barrier(unsigned* ctr, unsigned target) {
    asm volatile("s_waitcnt vmcnt(0) lgkmcnt(0)" ::: "memory");
    __syncthreads();
    if (threadIdx.x == 0) {
        __builtin_amdgcn_fence(__ATOMIC_RELEASE, "agent");
        asm volatile("s_waitcnt vmcnt(0)" ::: "memory");
        __hip_atomic_fetch_add(ctr, 1u, __ATOMIC_RELAXED, __HIP_MEMORY_SCOPE_AGENT);
        unsigned spins = 0;
        while (__hip_atomic_load(ctr, __ATOMIC_RELAXED, __HIP_MEMORY_SCOPE_AGENT) < target) { __builtin_amdgcn_s_sleep(2); if (++spins > (1u << 24)) break; }
        __builtin_amdgcn_fence(__ATOMIC_ACQUIRE, "agent");
        asm volatile("s_waitcnt vmcnt(0)" ::: "memory");
    }
    __syncthreads();
}
__device__ __forceinline__ void grid_barrier2(unsigned* ctl, unsigned x, unsigned nloc, unsigned nx, unsigned round) {
    asm volatile("s_waitcnt vmcnt(0) lgkmcnt(0)" ::: "memory");
    __syncthreads();
    if (threadIdx.x == 0) {
        const unsigned old = __hip_atomic_fetch_add(ctl + 2048 + 64 * x, 1u, __ATOMIC_RELAXED, __HIP_MEMORY_SCOPE_AGENT);
        if (old + 1u == round * nloc) {
            __builtin_amdgcn_fence(__ATOMIC_RELEASE, "agent");
            asm volatile("s_waitcnt vmcnt(0)" ::: "memory");
            __hip_atomic_fetch_add(ctl + 1280, 1u, __ATOMIC_RELAXED, __HIP_MEMORY_SCOPE_AGENT);
        }
        asm volatile("buffer_inv sc1" ::: "memory");
        unsigned spins = 0;
        while (__hip_atomic_load(ctl + 1280, __ATOMIC_RELAXED, __HIP_MEMORY_SCOPE_AGENT) < round * nx) { __builtin_amdgcn_s_sleep(1); if (++spins > (1u << 24)) break; }
        asm volatile("s_waitcnt vmcnt(0)" ::: "memory");
    }
    __syncthreads();
}
#define GRID_SYNC() do { if (two_level) { ++nsync2; grid_barrier2((unsigned*)a.ws, xcd_x, xcd_nloc, 8u, nsync2); } else { ++nsync; grid_barrier((unsigned*)a.ws, nsync * (unsigned)G); } } while (0)
__device__ __forceinline__ float bf_f(bf16_t v) { return __builtin_bit_cast(float, (unsigned)v << 16); }
__global__ void __launch_bounds__(512, 2) mega_fwd(Args a) {
    extern __shared__ __attribute__((aligned(16))) unsigned char lds_raw[];
    LAS unsigned char* lds = (LAS unsigned char*)lds_raw;
    cg::grid_group grid = cg::this_grid();
    const int tid = threadIdx.x, lane = tid & 63; const int wave = __builtin_amdgcn_readfirstlane(tid >> 6);
    const int G = gridDim.x, NGW = G * 8;
    unsigned nsync = 0;
    if (blockIdx.x == 0) for (int i = tid; i < 4096; i += 512) __hip_atomic_store((unsigned*)a.ws + i, 0u, __ATOMIC_RELAXED, __HIP_MEMORY_SCOPE_AGENT);
    asm volatile("s_waitcnt vmcnt(0)" ::: "memory");
    grid.sync();
    int bx; unsigned nsync2 = 0, xcd_x = 0, xcd_nloc = 1; bool two_level = false;
    unsigned char* ws = a.ws;
    { unsigned* ctl = (unsigned*)a.ws; volatile LAS unsigned* misc = (volatile LAS unsigned*)(lds + LDS_BYTES - 64);
      if (tid == 0) { const unsigned x = (unsigned)__builtin_amdgcn_s_getreg((3 << 11) | 20) & 0xFu;
                      misc[0] = x; misc[1] = __hip_atomic_fetch_add(ctl + 64 + 64 * x, 1u, __ATOMIC_RELAXED, __HIP_MEMORY_SCOPE_AGENT);
                      unsigned spins = 0;
                      for (;;) { unsigned sum = 0; for (unsigned j = 0; j < 16; ++j) sum += __hip_atomic_load(ctl + 64 + 64 * j, __ATOMIC_RELAXED, __HIP_MEMORY_SCOPE_AGENT);
                                 if (sum >= (unsigned)G || ++spins > (1u << 22)) break; __builtin_amdgcn_s_sleep(2); } }
      __syncthreads();
      const unsigned x = misc[0], rank = misc[1]; unsigned nx = 0, base = 0; bool equal = true;
      for (unsigned j = 0; j < 16; ++j) { const unsigned c = __hip_atomic_load(ctl + 64 + 64 * j, __ATOMIC_RELAXED, __HIP_MEMORY_SCOPE_AGENT);
          if (c) { ++nx; if (c != (unsigned)G / 8u) equal = false; } if (j < x) base += c; }
      const bool regular = equal && nx == 8 && x < 8;
      bx = __builtin_amdgcn_readfirstlane(regular ? (int)(rank * 8 + x) : (int)(base + rank));
      two_level = regular; xcd_x = (unsigned)__builtin_amdgcn_readfirstlane((int)x); xcd_nloc = (unsigned)G / 8u;
      prologue(a, lds, bx * 8 + wave, NGW, wave, lane);
      GRID_SYNC(); }
    const int gw = bx * 8 + wave;
    const int vcu = (G % 8 == 0) ? (bx % 8) * (G / 8) + bx / 8 : bx;
    float* ssq = (float*)(ws + WS_SSQP);
    bf16_t* xb = (bf16_t*)(ws + WS_XB); bf16_t* U = (bf16_t*)(ws + WS_BIG); bf16_t* qkv = (bf16_t*)(ws + WS_BIG);
    bf16_t* gates = (bf16_t*)(ws + WS_GATES); bf16_t* yb = (bf16_t*)(ws + WS_Y);
    bf16_t* ao = (bf16_t*)a.out; bf16_t* bo = ao + 512;

    for (int rep = 0; rep < NREP(2); ++rep) {
    if (PH & 2) { pg8::Gemm g{xb, (const bf16_t*)(ws + WS_WGU1), NTOK, 2 * DFF, DM}; pg8::StaticOrder S; S.init(NTOK, 2 * DFF, G, bx);
      pg8::EpiSwiGLU E{U, DFF, ssq};
      pg8::gemm_phase<pg8::EpiSwiGLU, pg8::StaticOrder, true, true>(lds, g, S, E);
      if (G == 256 && bx >= 128) prologue_items(a, lds, PI_E1, PI_E3, (bx - 128) * 8 + wave, 128 * 8, wave, lane);
      else if (G != 256) prologue_items(a, lds, PI_E1, PI_E3, gw, NGW, wave, lane); }
    GRID_SYNC(); }
    for (int rep = 0; rep < NREP(4); ++rep) {
    if (PH & 4) { pg8::Gemm g{U, (const bf16_t*)(ws + WS_WD1), NTOK, DM, DFF}; pg8::StaticOrder S; S.init(NTOK, DM, G, bx);
      pg8::EpiResidB E{nullptr, xb, ssq + SSQ_STRIDE, 0.5f};
      pg8::gemm_phase<pg8::EpiResidB, pg8::StaticOrder, true, true>(lds, g, S, E); }
    GRID_SYNC(); }
    for (int rep = 0; rep < NREP(8); ++rep) {
    if (PH & 8) { pg8::Gemm g{xb, (const bf16_t*)(ws + WS_WIN), NTOK, DIN, DM}; pg8::StaticOrder S; S.init(NTOK, DIN, G, bx);
      pg8::EpiProj E{qkv, gates, ssq + SSQ_STRIDE, a.in[7], att::C2_DA, att::C2_SB};
      pg8::gemm_phase<pg8::EpiProj, pg8::StaticOrder, true, true>(lds, g, S, E); }
    GRID_SYNC(); }
    if (PH & 16) {
        float lam;
        { const float s1 = wave_sum(a.in[8][lane] * a.in[9][lane]), s2 = wave_sum(a.in[10][lane] * a.in[11][lane]); lam = expf(s1) - expf(s2) + 0.2f; }
        for (int rep = 0; rep < NREP(1024); ++rep) if (PH & 1024) for (int pu = vcu; pu < 256; pu += G) { const int bh = pu >> 4, j = pu & 15, b = bh >> 2, h = bh & 3;
            att::diff_unit(lds, qkv, qkv + QKV_ELEMS, qkv + 2 * QKV_ELEMS, ao, b, h, 31 - j, lam, a.in[12]);
            att::diff_unit(lds, qkv, qkv + QKV_ELEMS, qkv + 2 * QKV_ELEMS, ao, b, h, j, lam, a.in[12]); }
        for (int rep = 0; rep < NREP(2048); ++rep) if (PH & 2048) for (int u = vcu; u < 256; u += G) { const int bh = u >> 4, qb = u & 15, b = bh >> 2, h = bh & 3;
            att::sb_unit(lds, qkv + 3 * QKV_ELEMS, qkv + 4 * QKV_ELEMS, qkv + 5 * QKV_ELEMS, bo, b, h, qb); }
    }
    GRID_SYNC();
    if (PH & 32) { pg8::Gemm g{ao, (const bf16_t*)(ws + WS_WAB), NTOK, 2 * DM, DM}; pg8::StaticOrder S; S.init(NTOK, 2 * DM, G, bx);
      pg8::EpiBranch2 E{yb, gates};
      pg8::gemm_phase<pg8::EpiBranch2, pg8::StaticOrder, true, true>(lds, g, S, E); }
    GRID_SYNC();
    if (PH & 64) { pg8::Gemm g{yb, (const bf16_t*)(ws + WS_WOUT), NTOK, DM, DM}; pg8::StaticOrder S; S.init(NTOK, DM, G, bx);
      pg8::EpiResidB E{nullptr, xb, ssq + 2 * SSQ_STRIDE, 1.0f};
      pg8::gemm_phase<pg8::EpiResidB, pg8::StaticOrder, true, true>(lds, g, S, E); }
    GRID_SYNC();
    if (PH & 128) { pg8::Gemm g{xb, (const bf16_t*)(ws + WS_WGU2), NTOK, 2 * DFF, DM}; pg8::StaticOrder S; S.init(NTOK, 2 * DFF, G, bx);
      pg8::EpiSwiGLU E{U, DFF, ssq + 2 * SSQ_STRIDE};
      pg8::gemm_phase<pg8::EpiSwiGLU, pg8::StaticOrder, true, true>(lds, g, S, E);
      if (G == 256 && bx >= 128) prologue_items(a, lds, PI_E8, PI_TOTAL, (bx - 128) * 8 + wave, 128 * 8, wave, lane);
      else if (G != 256) prologue_items(a, lds, PI_E8, PI_TOTAL, gw, NGW, wave, lane); }
    GRID_SYNC();
    if (PH & 256) { pg8::Gemm g{U, (const bf16_t*)(ws + WS_WD2), NTOK, DM, DFF}; pg8::StaticOrder S; S.init(NTOK, DM, G, bx);
      pg8::EpiResidB E{nullptr, xb, ssq + 3 * SSQ_STRIDE, 0.5f};
      pg8::gemm_phase<pg8::EpiResidB, pg8::StaticOrder, true, true>(lds, g, S, E); }
    GRID_SYNC();
    if (PH & 512) final_norm(a, G, bx, wave, lane);
#ifdef DBG_FINAL
    for (size_t i = (size_t)bx * 512 + tid; i < (size_t)NTOK * DM; i += (size_t)G * 512) {
        const int row = (int)(i >> 10), c = (int)(i & 1023), cc = c & 511, o = (c >> 9) * 3;
        float v = 0.f;
        if (DBG_FINAL == 1) v = bf_f(qkv[(size_t)(o + 0) * QKV_ELEMS + (size_t)row * 512 + cc]) + bf_f(qkv[(size_t)(o + 1) * QKV_ELEMS + (size_t)row * 512 + cc]) + bf_f(qkv[(size_t)(o + 2) * QKV_ELEMS + (size_t)row * 512 + cc])
                                + bf_f(gates[(size_t)row * 2048 + c]) + bf_f(gates[(size_t)row * 2048 + 1024 + c]);
        if (DBG_FINAL == 4) v = bf_f(gates[(size_t)row * 2048 + c]) + bf_f(gates[(size_t)row * 2048 + 1024 + c]);
        if (DBG_FINAL == 5) v = bf_f(qkv[(size_t)(o + 0) * QKV_ELEMS + (size_t)row * 512 + cc]) + bf_f(qkv[(size_t)(o + 1) * QKV_ELEMS + (size_t)row * 512 + cc]) + bf_f(qkv[(size_t)(o + 2) * QKV_ELEMS + (size_t)row * 512 + cc]);
        if (DBG_FINAL == 6) v = bf_f(U[(size_t)row * 2816 + c]) + bf_f(U[(size_t)row * 2816 + 1024 + c]) + (c < 768 ? bf_f(U[(size_t)row * 2816 + 2048 + c]) : 0.f);
        if (DBG_FINAL == 7) v = (row < 5120) ? bf_f(((const bf16_t*)(ws + WS_WIN))[(size_t)row * 1024 + c]) : 0.f;
        if (DBG_FINAL == 8) v = bf_f(ao[(size_t)row * 1024 + c]);
        if (DBG_FINAL == 9) v = (c < 512) ? bf_f(ao[(size_t)row * 512 + cc]) : 0.f;
        if (DBG_FINAL == 10) v = (c < 512) ? 0.f : bf_f(bo[(size_t)row * 512 + cc]);
        if (DBG_FINAL == 2) v = bf_f(yb[(size_t)row * 1024 + c]);
        if (DBG_FINAL == 3) v = bf_f(xb[i]) + ssq[SSQ_STRIDE + (size_t)row * 16 + (c & 15)];
        a.out[i] = v;
    }
#endif
}

extern "C" void kernel_launch(void* const* d_in, const int* in_sizes, int n_in, void* d_out, int out_size, void* d_ws, size_t ws_size, hipStream_t stream) {
    static int grid = 0;
    if (grid == 0) {
        if (n_in != 21 || out_size != NTOK * DM || ws_size < WS_END) { fprintf(stderr, "kernel_launch: unexpected problem shape (n_in %d out %d ws %zu)\n", n_in, out_size, ws_size); grid = -1; return; }
        int dev = 0, cus = 0, per_cu = 0;
        (void)hipGetDevice(&dev); (void)hipDeviceGetAttribute(&cus, hipDeviceAttributeMultiprocessorCount, dev);
        (void)hipFuncSetAttribute((const void*)mega_fwd, hipFuncAttributeMaxDynamicSharedMemorySize, LDS_BYTES);
        if (hipOccupancyMaxActiveBlocksPerMultiprocessor(&per_cu, (const void*)mega_fwd, 512, LDS_BYTES) != hipSuccess || per_cu < 1) per_cu = 1;
        (void)hipGetLastError();
        if (cus <= 0) cus = 256;
        grid = cus * per_cu;
    }
    if (grid < 0) return;
    Args a{};
    for (int i = 0; i < 21; ++i) a.in[i] = (const float*)d_in[i];
    a.out = (float*)d_out; a.ws = (unsigned char*)d_ws;
    void* args[] = {&a};
    hipError_t e = hipLaunchCooperativeKernel((const void*)mega_fwd, dim3(grid), dim3(512), args, LDS_BYTES, stream);
    if (e != hipSuccess) fprintf(stderr, "cooperative launch failed: %s (grid %d)\n", hipGetErrorString(e), grid);
}
```

```cpp
#include <hip/hip_runtime.h>
#include <hip/hip_cooperative_groups.h>
#include <cstdio>
#include <cstdint>
namespace cg = cooperative_groups;
namespace pg8 {
#define PG8_LAS __attribute__((address_space(3)))
typedef unsigned short bf16_t;
typedef short bf16x8 __attribute__((ext_vector_type(8)));
typedef float f32x4 __attribute__((ext_vector_type(4)));
typedef unsigned u32x4 __attribute__((ext_vector_type(4)));
constexpr int BM = 256, BK = 64, HALF = 128, HTB = HALF * BK * 2  , STAGE_BYTES = 8 * HTB, NXCD = 8, WGM = 8;

__host__ __device__ __forceinline__ int lds_byte(int r, int c) { const int st = (r >> 4) * 2 + (c >> 5), rr = r & 15, cc = c & 31, ob = rr * 64 + cc * 2; return st * 1024 + (ob ^ (((ob >> 9) & 1) << 5)); }
__host__ __device__ __forceinline__ void stage_rc(int b, int& R, int& C) { const int st = b / 1024, sb = b % 1024, swz = sb ^ (((sb >> 9) & 1) << 5); R = (st >> 1) * 16 + swz / 64; C = (st & 1) * 32 + (swz % 64) / 2; }
__host__ __device__ __forceinline__ int perm32(int rho) { const int n = rho >> 4, i = rho & 15; return 8 * (i >> 2) + 4 * n + (i & 3); }

struct Unit { int pm, pn; };
struct Gemm { const bf16_t* A; const bf16_t* Bt; int M, N, K; };

struct StaticOrder {
    int nM, nN, nwg, G, c;
    __host__ __device__ void init(int M, int N, int G_, int c_) { nM = M / BM; nN = N / BM; nwg = nM * nN; G = G_; c = c_; }
    __host__ __device__ bool next(int i, Unit& u) const {
        const long L = (long)i * G + c; if (L >= nwg) return false;
        int wgid = (int)L; { const int q = nwg / NXCD, r = nwg % NXCD, xcd = wgid % NXCD, off = wgid / NXCD; wgid = (xcd < r ? xcd * (q + 1) : r * (q + 1) + (xcd - r) * q) + off; }
        const int nig = WGM * nN, gid = wgid / nig, fm = gid * WGM, gsz = (nM - fm) < WGM ? (nM - fm) : WGM;
        u.pm = fm + ((wgid % nig) % gsz); u.pn = (wgid % nig) / gsz; return true;
    }
    __device__ __forceinline__ void a_ready(const Unit&) const {}
    __device__ __forceinline__ void done(const Unit&) const {}
};
__device__ __forceinline__ unsigned cvt_pk_bf16(float lo, float hi) { unsigned r; asm volatile("v_cvt_pk_bf16_f32 %0, %1, %2" : "=v"(r) : "v"(lo), "v"(hi)); return r; }
typedef float f32x2 __attribute__((ext_vector_type(2)));
typedef unsigned u32x2 __attribute__((ext_vector_type(2)));
constexpr float NORM_EPS_ = 1e-5f;
__device__ __forceinline__ float row_rstd(const float* ss, int row, int fq) {
    const f32x4 a = ((const f32x4*)(ss + (size_t)row * 16))[fq];
    float s = (a[0] + a[1]) + (a[2] + a[3]);
    s += __shfl_xor(s, 16); s += __shfl_xor(s, 32);
    return __builtin_amdgcn_rsqf(s * (1.0f / 1024.0f) + NORM_EPS_); }
__device__ __forceinline__ float fast_sigmoid(float v) { return __builtin_amdgcn_rcpf(1.0f + __builtin_amdgcn_exp2f(-1.4426950408889634f * v)); }
__device__ __forceinline__ float bf_lo(unsigned w) { return __builtin_bit_cast(float, w << 16); }
__device__ __forceinline__ float bf_hi(unsigned w) { return __builtin_bit_cast(float, w & 0xffff0000u); }

struct EpiSwiGLU {
    static constexpr bool PERM = true, AFTER_DRAIN = false;
    bf16_t* U; int ldu; const float* ss;
    __device__ __forceinline__ void operator()(const f32x4 (&acc)[2][2][4][2], const Unit& u, int wr, int wc, int fr, int fq) const {
        const int row0 = u.pm * BM + wr * 64 + fr, col0 = u.pn * HALF + wc * 32 + 8 * fq;
#pragma unroll
        for (int ai = 0; ai < 2; ++ai)
#pragma unroll
            for (int m = 0; m < 4; ++m) {
                const int row = row0 + ai * HALF + m * 16; const float r = row_rstd(ss, row, fq);
                float o[8];
#pragma unroll
                for (int n = 0; n < 2; ++n)
#pragma unroll
                    for (int e = 0; e < 4; ++e) { const float g = acc[ai][0][m][n][e] * r, up = acc[ai][1][m][n][e] * r; o[n * 4 + e] = g * fast_sigmoid(g) * up; }
                u32x4 w; w.x = cvt_pk_bf16(o[0], o[1]); w.y = cvt_pk_bf16(o[2], o[3]); w.z = cvt_pk_bf16(o[4], o[5]); w.w = cvt_pk_bf16(o[6], o[7]);
                *(u32x4*)(U + (size_t)row * ldu + col0) = w;
            }
    }
};

struct EpiResid {
    static constexpr bool PERM = false, AFTER_DRAIN = false;
    const float* base; float* out; bf16_t* hb; float* ssq; float alpha;
    __device__ __forceinline__ void operator()(const f32x4 (&acc)[2][2][4][2], const Unit& u, int wr, int wc, int fr, int fq) const {
        const int row0 = u.pm * BM + wr * 64 + fr, col0 = u.pn * BM + wc * 32 + 4 * fq;
#pragma unroll
        for (int ai = 0; ai < 2; ++ai)
#pragma unroll
            for (int m = 0; m < 4; ++m) {
                const int row = row0 + ai * HALF + m * 16; const size_t off = (size_t)row * 1024 + col0; float sq = 0.f;
#pragma unroll
                for (int bj = 0; bj < 2; ++bj)
#pragma unroll
                    for (int n = 0; n < 2; ++n) {
                        const f32x4 b = *(const f32x4*)(base + off + bj * HALF + n * 16);
                        const f32x4 v = b + acc[ai][bj][m][n] * alpha;
                        *(f32x4*)(out + off + bj * HALF + n * 16) = v;
                        sq += (v[0] * v[0] + v[1] * v[1]) + (v[2] * v[2] + v[3] * v[3]);
                        if (hb) { u32x2 w; w.x = cvt_pk_bf16(v[0], v[1]); w.y = cvt_pk_bf16(v[2], v[3]); *(u32x2*)(hb + off + bj * HALF + n * 16) = w; }
                    }
                sq += __shfl_xor(sq, 16); sq += __shfl_xor(sq, 32);
                if (fq == 0) ssq[(size_t)row * 16 + u.pn * 4 + wc] = sq;
            }
    }
};

struct EpiResidB {
    static constexpr bool PERM = true, AFTER_DRAIN = false;
    const float* basef; bf16_t* hb; float* ssq; float alpha;
    __device__ __forceinline__ void operator()(const f32x4 (&acc)[2][2][4][2], const Unit& u, int wr, int wc, int fr, int fq) const {
        const int row0 = u.pm * BM + wr * 64 + fr, col0 = u.pn * BM + wc * 32 + 8 * fq;
#pragma unroll
        for (int ai = 0; ai < 2; ++ai) {
            u32x4 bh[4][2];
#pragma unroll
            for (int m = 0; m < 4; ++m)
#pragma unroll
                for (int bj = 0; bj < 2; ++bj) bh[m][bj] = *(const u32x4*)(hb + (size_t)(row0 + ai * HALF + m * 16) * 1024 + col0 + bj * HALF);
#pragma unroll
            for (int m = 0; m < 4; ++m) {
                const int row = row0 + ai * HALF + m * 16; const size_t off = (size_t)row * 1024 + col0; float sq = 0.f;
#pragma unroll
                for (int bj = 0; bj < 2; ++bj) {
                    const u32x4 p = bh[m][bj];
                    const f32x4 b0 = (f32x4){bf_lo(p.x), bf_hi(p.x), bf_lo(p.y), bf_hi(p.y)}, b1 = (f32x4){bf_lo(p.z), bf_hi(p.z), bf_lo(p.w), bf_hi(p.w)};
                    const f32x4 v0 = b0 + acc[ai][bj][m][0] * alpha, v1 = b1 + acc[ai][bj][m][1] * alpha;
                    sq += ((v0[0] * v0[0] + v0[1] * v0[1]) + (v0[2] * v0[2] + v0[3] * v0[3])) + ((v1[0] * v1[0] + v1[1] * v1[1]) + (v1[2] * v1[2] + v1[3] * v1[3]));
                    u32x4 w; w.x = cvt_pk_bf16(v0[0], v0[1]); w.y = cvt_pk_bf16(v0[2], v0[3]); w.z = cvt_pk_bf16(v1[0], v1[1]); w.w = cvt_pk_bf16(v1[2], v1[3]);
                    *(u32x4*)(hb + off + bj * HALF) = w;
                }
                sq += __shfl_xor(sq, 16); sq += __shfl_xor(sq, 32);
                if (fq == 0) ssq[(size_t)row * 16 + u.pn * 4 + wc] = sq;
            }
        }
    }
};

struct EpiProj {
    static constexpr bool PERM = true, AFTER_DRAIN = false;
    bf16_t* qkv; bf16_t* gates; const float* ss; const float* bgate; float sc_da, sc_sb;
    __device__ __forceinline__ void operator()(const f32x4 (&acc)[2][2][4][2], const Unit& u, int wr, int wc, int fr, int fq) const {
        const int row0 = u.pm * BM + wr * 64 + fr;
        if (u.pn >= 8) {
            const int t = (u.pn - 8) >> 1; const float sc = (t == 0) ? sc_da : ((t == 3) ? sc_sb : 1.0f);
            bf16_t* dst = qkv + (size_t)t * ((size_t)16384 * 512); const int col0 = ((u.pn - 8) & 1) * BM + wc * 32 + 8 * fq;
#pragma unroll
            for (int ai = 0; ai < 2; ++ai)
#pragma unroll
                for (int m = 0; m < 4; ++m) {
                    const int row = row0 + ai * HALF + m * 16; const float r = row_rstd(ss, row, fq) * sc;
#pragma unroll
                    for (int bj = 0; bj < 2; ++bj) {
                        const f32x4 v0 = acc[ai][bj][m][0] * r, v1 = acc[ai][bj][m][1] * r;
                        u32x4 w; w.x = cvt_pk_bf16(v0[0], v0[1]); w.y = cvt_pk_bf16(v0[2], v0[3]); w.z = cvt_pk_bf16(v1[0], v1[1]); w.w = cvt_pk_bf16(v1[2], v1[3]);
                        *(u32x4*)(dst + (size_t)row * 512 + col0 + bj * HALF) = w;
                    }
                }
        } else {
            const int col0 = u.pn * BM + wc * 32 + 8 * fq;
            f32x4 bv[2][2];
#pragma unroll
            for (int bj = 0; bj < 2; ++bj)
#pragma unroll
                for (int n = 0; n < 2; ++n) bv[bj][n] = *(const f32x4*)(bgate + col0 + bj * HALF + 4 * n);
#pragma unroll
            for (int ai = 0; ai < 2; ++ai)
#pragma unroll
                for (int m = 0; m < 4; ++m) {
                    const int row = row0 + ai * HALF + m * 16; const float r = row_rstd(ss, row, fq);
#pragma unroll
                    for (int bj = 0; bj < 2; ++bj) {
                        float o[8];
#pragma unroll
                        for (int n = 0; n < 2; ++n)
#pragma unroll
                            for (int e = 0; e < 4; ++e) o[n * 4 + e] = fast_sigmoid(acc[ai][bj][m][n][e] * r + bv[bj][n][e]);
                        u32x4 w; w.x = cvt_pk_bf16(o[0], o[1]); w.y = cvt_pk_bf16(o[2], o[3]); w.z = cvt_pk_bf16(o[4], o[5]); w.w = cvt_pk_bf16(o[6], o[7]);
                        *(u32x4*)(gates + (size_t)row * 2048 + col0 + bj * HALF) = w;
                    }
                }
        }
    }
};

struct EpiBranch2 {
    static constexpr bool PERM = true, AFTER_DRAIN = false;
    bf16_t* y; const bf16_t* gates;
    __device__ __forceinline__ void operator()(const f32x4 (&acc)[2][2][4][2], const Unit& u, int wr, int wc, int fr, int fq) const {
        const int row0 = u.pm * BM + wr * 64 + fr, col0 = u.pn * HALF + wc * 32 + 8 * fq;
#pragma unroll
        for (int ai = 0; ai < 2; ++ai)
#pragma unroll
            for (int m = 0; m < 4; ++m) {
                const int row = row0 + ai * HALF + m * 16;
                const u32x4 ga = *(const u32x4*)(gates + (size_t)row * 2048 + col0), gb = *(const u32x4*)(gates + (size_t)row * 2048 + 1024 + col0);
                const f32x4 a0 = acc[ai][0][m][0], a1 = acc[ai][0][m][1], b0 = acc[ai][1][m][0], b1 = acc[ai][1][m][1];
                u32x4 w;
                w.x = cvt_pk_bf16(bf_lo(ga.x) * a0[0] + bf_lo(gb.x) * b0[0], bf_hi(ga.x) * a0[1] + bf_hi(gb.x) * b0[1]);
                w.y = cvt_pk_bf16(bf_lo(ga.y) * a0[2] + bf_lo(gb.y) * b0[2], bf_hi(ga.y) * a0[3] + bf_hi(gb.y) * b0[3]);
                w.z = cvt_pk_bf16(bf_lo(ga.z) * a1[0] + bf_lo(gb.z) * b1[0], bf_hi(ga.z) * a1[1] + bf_hi(gb.z) * b1[1]);
                w.w = cvt_pk_bf16(bf_lo(ga.w) * a1[2] + bf_lo(gb.w) * b1[2], bf_hi(ga.w) * a1[3] + bf_hi(gb.w) * b1[3]);
                *(u32x4*)(y + (size_t)row * 1024 + col0) = w;
            }
    }
};
#ifndef PG8_EPI_DRAIN
#define PG8_EPI_DRAIN() do {} while (0)
#endif
template <class Epi, class Sched, bool ALIGN_EPI = false, bool SP2 = false>
__device__ __forceinline__ void gemm_phase(PG8_LAS unsigned char* lds, const Gemm g, const Sched& S, const Epi& E) {
    int tid_ = threadIdx.x; asm volatile("" : "+v"(tid_));
    const int tid = tid_, wid = __builtin_amdgcn_readfirstlane(tid >> 6), lane = tid & 63, wr = wid >> 2, wc = wid & 3, fr = lane & 15, fq = lane >> 4;
    const int K = g.K, nt = K / BK;
    unsigned voffA[2], voffB[2];
#pragma unroll
    for (int i = 0; i < 2; ++i) { int R, C; stage_rc(tid * 16 + i * 8192, R, C); const int Rb = Epi::PERM ? ((R & ~31) + perm32(R & 31)) : R;
        voffA[i] = (unsigned)(R * K + C) * 2u; voffB[i] = (unsigned)(Rb * K + C) * 2u; }
    const size_t kstep = (size_t)(BK * 2);
    const size_t hstep = (size_t)HALF * K * 2;
    const size_t tstep = 2 * hstep;
    const unsigned ldsw = (unsigned)wid * 1024u;
    const int aoff = lds_byte(wr * 64 + fr, fq * 8), boff = lds_byte(wc * 32 + fr, fq * 8);
#define PG8_SA(b, h) (((b) * 2 + (h)) * HTB)
#define PG8_SB(b, h) ((4 + (b) * 2 + (h)) * HTB)
#define PG8_STAGE(bufoff, gbase, voff) do { _Pragma("unroll") for (int _i = 0; _i < 2; ++_i) \
        __builtin_amdgcn_global_load_lds((const unsigned*)((const char*)(gbase) + (voff)[_i]), (PG8_LAS unsigned*)(lds + (bufoff) + ldsw + _i * 8192), 16, 0, 0); } while (0)
#define PG8_LDA(dst, b, h) do { _Pragma("unroll") for (int m = 0; m < 4; ++m) _Pragma("unroll") for (int k = 0; k < 2; ++k) dst[m][k] = *(const PG8_LAS bf16x8*)(lds + PG8_SA(b, h) + aoff + m * 2048 + k * 1024); } while (0)
#define PG8_LDB(dst, b, h) do { _Pragma("unroll") for (int n = 0; n < 2; ++n) _Pragma("unroll") for (int k = 0; k < 2; ++k) dst[n][k] = *(const PG8_LAS bf16x8*)(lds + PG8_SB(b, h) + boff + n * 2048 + k * 1024); } while (0)
#define PG8_MMA(ai, bj, At, Bt) do { __builtin_amdgcn_s_setprio(1); _Pragma("unroll") for (int m = 0; m < 4; ++m) _Pragma("unroll") for (int n = 0; n < 2; ++n) _Pragma("unroll") for (int k = 0; k < 2; ++k) \
        acc[ai][bj][m][n] = __builtin_amdgcn_mfma_f32_16x16x32_bf16(Bt[n][k], At[m][k], acc[ai][bj][m][n], 0, 0, 0); __builtin_amdgcn_s_setprio(0); } while (0)
#define PG8_WAIT_V(n) asm volatile("s_waitcnt vmcnt(" #n ")" ::: "memory")
#define PG8_WAIT_L(n) asm volatile("s_waitcnt lgkmcnt(" #n ")" ::: "memory")
#define PG8_BAR __builtin_amdgcn_s_barrier()
#define PG8_SCHED __builtin_amdgcn_sched_barrier(0)
    Unit cur, nxt; int ui = 0;
    if (!S.next(0, cur)) return;
    f32x4 acc[2][2][4][2];
#pragma unroll
    for (int a = 0; a < 2; ++a)
#pragma unroll
        for (int b = 0; b < 2; ++b)
#pragma unroll
            for (int m = 0; m < 4; ++m)
#pragma unroll
                for (int n = 0; n < 2; ++n) acc[a][b][m][n] = (f32x4){0.f, 0.f, 0.f, 0.f};
    bf16x8 At[4][2], B0[2][2], B1[2][2];
    const char* cA = (const char*)g.A + (size_t)cur.pm * tstep; const char* cB = (const char*)g.Bt + (size_t)cur.pn * tstep;
    S.a_ready(cur);
    if constexpr (SP2) {
        PG8_STAGE(PG8_SB(0, 0), cB, voffB); PG8_STAGE(PG8_SB(0, 1), cB + hstep, voffB); PG8_STAGE(PG8_SA(0, 0), cA, voffA); PG8_STAGE(PG8_SA(0, 1), cA + hstep, voffA);
        if (wr == 1) PG8_BAR;
        PG8_WAIT_V(2); PG8_BAR;
        PG8_STAGE(PG8_SB(1, 0), cB + kstep, voffB); PG8_STAGE(PG8_SA(1, 0), cA + kstep, voffA); PG8_STAGE(PG8_SB(1, 1), cB + hstep + kstep, voffB);
        PG8_WAIT_V(6); PG8_BAR;
    } else {
        PG8_STAGE(PG8_SB(0, 0), cB, voffB); PG8_STAGE(PG8_SA(0, 0), cA, voffA); PG8_STAGE(PG8_SB(0, 1), cB + hstep, voffB); PG8_STAGE(PG8_SA(0, 1), cA + hstep, voffA);
        if (wr == 1) PG8_BAR;
        PG8_WAIT_V(4); PG8_BAR;
        PG8_STAGE(PG8_SB(1, 0), cB + kstep, voffB); PG8_STAGE(PG8_SA(1, 0), cA + kstep, voffA); PG8_STAGE(PG8_SB(1, 1), cB + hstep + kstep, voffB);
        PG8_WAIT_V(6); PG8_BAR;
    }
    for (;;) {
        const bool has_next = S.next(ui + 1, nxt);
        const char* nA = has_next ? (const char*)g.A + (size_t)nxt.pm * tstep : cA; const char* nB = has_next ? (const char*)g.Bt + (size_t)nxt.pn * tstep : cB;
        for (int t = 0; t < nt; t += 2) {
            const bool last = (t == nt - 2);
            const char* a1 = cA + (size_t)(t + 1) * kstep;
            const char* a2 = last ? nA : cA + (size_t)(t + 2) * kstep; const char* b2 = last ? nB : cB + (size_t)(t + 2) * kstep;
            const char* a3 = a2 + kstep; const char* b3 = b2 + kstep;
            if (last && has_next) S.a_ready(nxt);
            if constexpr (SP2) {
            PG8_LDB(B0, 0, 0); PG8_LDB(B1, 0, 1); PG8_SCHED; PG8_LDA(At, 0, 0); PG8_STAGE(PG8_SA(1, 1), a1 + hstep, voffA);
            PG8_WAIT_V(8); PG8_WAIT_L(0); PG8_BAR; PG8_MMA(0, 0, At, B0); PG8_MMA(0, 1, At, B1); PG8_BAR; PG8_SCHED;
            PG8_LDA(At, 0, 1); PG8_STAGE(PG8_SB(0, 0), b2, voffB); PG8_STAGE(PG8_SB(0, 1), b2 + hstep, voffB); PG8_STAGE(PG8_SA(0, 0), a2, voffA);
            PG8_WAIT_V(8); PG8_WAIT_L(0); PG8_BAR; PG8_MMA(1, 0, At, B0); PG8_MMA(1, 1, At, B1); PG8_BAR; PG8_SCHED;
            PG8_LDB(B0, 1, 0); PG8_LDB(B1, 1, 1); PG8_SCHED; PG8_LDA(At, 1, 0); PG8_STAGE(PG8_SA(0, 1), a2 + hstep, voffA);
            PG8_WAIT_V(8); PG8_WAIT_L(0); PG8_BAR; PG8_MMA(0, 0, At, B0); PG8_MMA(0, 1, At, B1); PG8_BAR; PG8_SCHED;
            PG8_LDA(At, 1, 1); PG8_STAGE(PG8_SB(1, 0), b3, voffB); PG8_STAGE(PG8_SB(1, 1), b3 + hstep, voffB); PG8_STAGE(PG8_SA(1, 0), a3, voffA);
            PG8_WAIT_V(8); PG8_WAIT_L(0); PG8_BAR; PG8_MMA(1, 0, At, B0); PG8_MMA(1, 1, At, B1); PG8_BAR; PG8_SCHED;
            } else {
            PG8_LDB(B0, 0, 0); PG8_SCHED; PG8_LDA(At, 0, 0); PG8_STAGE(PG8_SA(1, 1), a1 + hstep, voffA);
            PG8_WAIT_L(8); PG8_BAR; PG8_WAIT_L(0); PG8_MMA(0, 0, At, B0); PG8_BAR; PG8_SCHED;
            PG8_LDB(B1, 0, 1); PG8_STAGE(PG8_SB(0, 0), b2, voffB);
            PG8_BAR; PG8_WAIT_L(0); PG8_MMA(0, 1, At, B1); PG8_BAR;
            PG8_LDA(At, 0, 1); PG8_STAGE(PG8_SA(0, 0), a2, voffA);
            PG8_BAR; PG8_WAIT_L(0); PG8_MMA(1, 0, At, B0); PG8_BAR; PG8_SCHED;
            PG8_STAGE(PG8_SB(0, 1), b2 + hstep, voffB);
            PG8_WAIT_V(6); PG8_BAR; PG8_MMA(1, 1, At, B1); PG8_BAR;
            PG8_LDB(B0, 1, 0); PG8_SCHED; PG8_LDA(At, 1, 0); PG8_STAGE(PG8_SA(0, 1), a2 + hstep, voffA);
            PG8_WAIT_L(8); PG8_BAR; PG8_WAIT_L(0); PG8_MMA(0, 0, At, B0); PG8_BAR; PG8_SCHED;
            PG8_LDB(B1, 1, 1); PG8_STAGE(PG8_SB(1, 0), b3, voffB);
            PG8_BAR; PG8_WAIT_L(0); PG8_MMA(0, 1, At, B1); PG8_BAR;
            PG8_LDA(At, 1, 1); PG8_STAGE(PG8_SA(1, 0), a3, voffA);
            PG8_BAR; PG8_WAIT_L(0); PG8_MMA(1, 0, At, B0); PG8_BAR; PG8_SCHED;
            PG8_STAGE(PG8_SB(1, 1), b3 + hstep, voffB);
            PG8_WAIT_V(6); PG8_BAR; PG8_MMA(1, 1, At, B1); PG8_BAR;
            }
        }
        if constexpr (ALIGN_EPI) { if (wr == 0) PG8_BAR; }
        if constexpr (!Epi::AFTER_DRAIN) { PG8_EPI_DRAIN(); E(acc, cur, wr, wc, fr, fq); PG8_EPI_DRAIN(); S.done(cur); }
        if (!has_next) break;
#pragma unroll
        for (int a = 0; a < 2; ++a)
#pragma unroll
            for (int b = 0; b < 2; ++b)
#pragma unroll
                for (int m = 0; m < 4; ++m)
#pragma unroll
                    for (int n = 0; n < 2; ++n) acc[a][b][m][n] = (f32x4){0.f, 0.f, 0.f, 0.f};
        cur = nxt; cA = nA; cB = nB; ++ui;
        if constexpr (ALIGN_EPI) { if (wr == 1) PG8_BAR; }
    }
    PG8_WAIT_V(0);
    if constexpr (!ALIGN_EPI) { if (wr == 0) PG8_BAR; }
    PG8_BAR;
    if constexpr (Epi::AFTER_DRAIN) { E.fused(acc, cur, wr, wc, fr, fq, lds, wid, lane); S.done(cur); }
#undef PG8_SA
#undef PG8_SB
#undef PG8_STAGE
#undef PG8_LDA
#undef PG8_LDB
#undef PG8_MMA
#undef PG8_WAIT_V
#undef PG8_WAIT_L
#undef PG8_BAR
#undef PG8_SCHED
}
}

#define LAS __attribute__((address_space(3)))
typedef unsigned short bf16_t;
typedef short bf16x8 __attribute__((ext_vector_type(8)));
typedef float f32x4 __attribute__((ext_vector_type(4)));
typedef float f32x16 __attribute__((ext_vector_type(16)));
typedef unsigned u32x4 __attribute__((ext_vector_type(4)));
typedef unsigned u32x2 __attribute__((ext_vector_type(2)));
typedef short v4i16_t __attribute__((ext_vector_type(4)));

constexpr int NTOK = 16384, DM = 1024, DFF = 2816, DIN = 5120, SEQ = 4096;
constexpr size_t MiB = (size_t)1 << 20;
constexpr size_t WS_SSQ = 0;
constexpr size_t WS_WGU1 = 1 * MiB, WS_WD1 = 12 * MiB, WS_WIN = WS_WD1 + 11 * MiB / 2, WS_WA = WS_WIN + 10 * MiB, WS_WB = WS_WA + 1 * MiB, WS_WOUT = WS_WB + 1 * MiB,
                 WS_WGU2 = WS_WOUT + 2 * MiB, WS_WD2 = WS_WGU2 + 11 * MiB;
constexpr size_t WS_XB = 48 * MiB;
constexpr size_t WS_BIG = 80 * MiB;
constexpr size_t WS_GATES = 176 * MiB;
constexpr size_t WS_Y = WS_BIG + 16 * MiB;
constexpr size_t WS_SSQP = 240 * MiB;
constexpr size_t SSQ_STRIDE = (size_t)NTOK * 16;
constexpr size_t WS_WAB = 244 * MiB;
constexpr size_t WS_END = 248 * MiB;
static_assert(WS_WD2 + 11 * MiB / 2 == 48 * MiB, "weight map");
constexpr size_t QKV_ELEMS = (size_t)NTOK * 512;
constexpr int LDS_BYTES = 147456;

__device__ __forceinline__ float wave_sum(float v) {
#pragma unroll
    for (int o = 1; o < 64; o <<= 1) v += __shfl_xor(v, o);
    return v;
}
__device__ __forceinline__ unsigned cvtpk(float lo, float hi) { unsigned r; asm volatile("v_cvt_pk_bf16_f32 %0, %1, %2" : "=v"(r) : "v"(lo), "v"(hi)); return r; }

struct PItem { const float* W; const float* gain; bf16_t* WT; int N, pitch, drow, kdst, zoff, k0, n0; };
struct Args { const float* in[21]; float* out; unsigned char* ws; };
__device__ __forceinline__ PItem p0_decode(const Args& a, int it) {
    unsigned char* ws = a.ws;
    constexpr int C_UP = (DM / 64) * (DFF / 32), C_DN = (DFF / 64) * (DM / 32), C_IN = (DM / 64) * (DIN / 32), C_BR = (512 / 64) * (DM / 32), C_OUT = (DM / 64) * (DM / 32);
    constexpr int E0 = C_UP, E1 = E0 + C_UP, E2 = E1 + C_DN, E3 = E2 + C_IN, E4 = E3 + C_BR, E5 = E4 + C_BR, E6 = E5 + C_OUT, E7 = E6 + C_UP, E8 = E7 + C_UP;
    int r = it, mi = 0;
    if (it >= E8) { mi = 9; r = it - E8; } else if (it >= E7) { mi = 8; r = it - E7; } else if (it >= E6) { mi = 7; r = it - E6; } else if (it >= E5) { mi = 6; r = it - E5; }
    else if (it >= E4) { mi = 5; r = it - E4; } else if (it >= E3) { mi = 4; r = it - E3; } else if (it >= E2) { mi = 3; r = it - E2; } else if (it >= E1) { mi = 2; r = it - E1; }
    else if (it >= E0) { mi = 1; r = it - E0; }
    const float* W = a.in[2]; const float* gp = nullptr; int K = DM, N = DFF, mode = 0; size_t doff = WS_WGU1;
    switch (mi) {
        case 0: W = a.in[2]; gp = a.in[1]; K = DM; N = DFF;  mode = 1; doff = WS_WGU1; break;
        case 1: W = a.in[3]; gp = a.in[1]; K = DM; N = DFF;  mode = 2; doff = WS_WGU1; break;
        case 2: W = a.in[4]; gp = nullptr; K = DFF; N = DM; mode = 0; doff = WS_WD1;  break;
        case 3: W = a.in[6]; gp = a.in[5]; K = DM; N = DIN;  mode = 0; doff = WS_WIN;  break;
        case 4: W = a.in[13]; gp = nullptr; K = 512; N = DM; mode = 3; doff = WS_WAB;  break;
        case 5: W = a.in[14]; gp = nullptr; K = 512; N = DM; mode = 4; doff = WS_WAB;  break;
        case 6: W = a.in[15]; gp = nullptr; K = DM; N = DM; mode = 0; doff = WS_WOUT; break;
        case 7: W = a.in[17]; gp = a.in[16]; K = DM; N = DFF; mode = 1; doff = WS_WGU2; break;
        case 8: W = a.in[18]; gp = a.in[16]; K = DM; N = DFF; mode = 2; doff = WS_WGU2; break;
        default: W = a.in[19]; gp = nullptr; K = DFF; N = DM; mode = 0; doff = WS_WD2;  break;
    }
    const int nblk = N / 32, kb = r / nblk, nb = r % nblk, k0 = 64 * kb, n0 = 32 * nb;
    PItem p; p.W = W; p.gain = gp; p.WT = (bf16_t*)(ws + doff); p.N = N; p.pitch = K; p.k0 = k0; p.n0 = n0; p.kdst = k0; p.zoff = -1;
    int drow = n0; if (mi == 3) drow = (n0 >= 3072) ? n0 - 3072 : n0 + 2048;
    if (mode == 1 || mode == 2) drow = (n0 >> 7) * 256 + (n0 & 127) + (mode == 2 ? 128 : 0);
    if (mode >= 3) {
        drow = (n0 >> 7) * 256 + (n0 & 127) + (mode == 4 ? 128 : 0); p.pitch = 1024; p.kdst = k0 + (mode == 4 ? 512 : 0); p.zoff = k0 + (mode == 4 ? 0 : 512); }
    p.drow = drow;
    return p;
}
__device__ __forceinline__ void p0_load(const PItem& p, float (&w)[32], int lane) {
#pragma unroll
    for (int i = 0; i < 32; ++i) { const int kk = 2 * i + (lane >> 5); w[i] = p.W[(size_t)(p.k0 + kk) * p.N + p.n0 + (lane & 31)]; }
}
__device__ __forceinline__ void p0_store(const PItem& p, const float (&w)[32], LAS float* scr, int lane) {
#pragma unroll
    for (int i = 0; i < 32; ++i) scr[(2 * i + (lane >> 5)) * 33 + (lane & 31)] = w[i];
    asm volatile("s_waitcnt lgkmcnt(0)" ::: "memory");
    const int c = lane & 7;
    f32x4 g0 = (f32x4){1.f, 1.f, 1.f, 1.f}, g1 = g0;
    if (p.gain) { g0 = *(const f32x4*)(p.gain + p.k0 + 8 * c); g1 = *(const f32x4*)(p.gain + p.k0 + 8 * c + 4); }
#pragma unroll
    for (int j = 0; j < 4; ++j) { const int n = (lane >> 3) + 8 * j; const LAS float* s = scr + (8 * c) * 33 + n;
        u32x4 o; o.x = cvtpk(s[0 * 33] * g0[0], s[1 * 33] * g0[1]); o.y = cvtpk(s[2 * 33] * g0[2], s[3 * 33] * g0[3]); o.z = cvtpk(s[4 * 33] * g1[0], s[5 * 33] * g1[1]); o.w = cvtpk(s[6 * 33] * g1[2], s[7 * 33] * g1[3]);
        bf16_t* row = p.WT + (size_t)(p.drow + n) * p.pitch;
        *(u32x4*)(row + p.kdst + 8 * c) = o;
        if (p.zoff >= 0) *(u32x4*)(row + p.zoff + 8 * c) = (u32x4){0u, 0u, 0u, 0u}; }
    asm volatile("s_waitcnt lgkmcnt(0)" ::: "memory");
}
__device__ __forceinline__ void prologue_items(const Args& a, LAS unsigned char* lds, int lo, int hi, int gw, int NGW, int wave, int lane) {
    LAS float* scr = (LAS float*)(lds + wave * 16384);
    for (int it = lo + gw; it < hi; it += 2 * NGW) {
        const bool has1 = (it + NGW < hi);
        const PItem p0 = p0_decode(a, it), p1 = p0_decode(a, has1 ? it + NGW : it);
        float w0[32], w1[32];
        p0_load(p0, w0, lane); if (has1) p0_load(p1, w1, lane);
        p0_store(p0, w0, scr, lane); if (has1) p0_store(p1, w1, scr, lane);
    }
}
constexpr int PI_E1 = 2 * (DM / 64) * (DFF / 32), PI_E3 = 6 * (DM / 64) * (DFF / 32) + (DM / 64) * (DIN / 32) + 2 * (512 / 64) * (DM / 32) + (DM / 64) * (DM / 32) - (DFF / 64) * (DM / 32);
constexpr int PI_TOTAL = 6 * (DM / 64) * (DFF / 32) + (DM / 64) * (DIN / 32) + 2 * (512 / 64) * (DM / 32) + (DM / 64) * (DM / 32), PI_E8 = PI_TOTAL - (DFF / 64) * (DM / 32);
__device__ __forceinline__ void prologue(const Args& a, LAS unsigned char* lds, int gw, int NGW, int wave, int lane) {
    unsigned char* ws = a.ws;
    prologue_items(a, lds, 0, PI_E1, gw, NGW, wave, lane);
    prologue_items(a, lds, PI_E3, PI_E8, gw, NGW, wave, lane);
    float* ssq = (float*)(ws + WS_SSQP); bf16_t* xb = (bf16_t*)(ws + WS_XB);
    for (int m = gw; m < NTOK; m += 2 * NGW) {
        const int m1 = m + NGW;
        const f32x4* xr0 = (const f32x4*)(a.in[0] + (size_t)m * DM) + lane; const f32x4* xr1 = (const f32x4*)(a.in[0] + (size_t)m1 * DM) + lane;
        f32x4 v0[4], v1[4];
#pragma unroll
        for (int j = 0; j < 4; ++j) { v0[j] = xr0[64 * j]; v1[j] = xr1[64 * j]; }
        float s0 = 0.f, s1 = 0.f;
        unsigned long long* o0 = (unsigned long long*)(xb + (size_t)m * DM) + lane; unsigned long long* o1 = (unsigned long long*)(xb + (size_t)m1 * DM) + lane;
#pragma unroll
        for (int j = 0; j < 4; ++j) {
            s0 += (v0[j][0] * v0[j][0] + v0[j][1] * v0[j][1]) + (v0[j][2] * v0[j][2] + v0[j][3] * v0[j][3]);
            s1 += (v1[j][0] * v1[j][0] + v1[j][1] * v1[j][1]) + (v1[j][2] * v1[j][2] + v1[j][3] * v1[j][3]);
            o0[64 * j] = (unsigned long long)cvtpk(v0[j][0], v0[j][1]) | ((unsigned long long)cvtpk(v0[j][2], v0[j][3]) << 32);
            o1[64 * j] = (unsigned long long)cvtpk(v1[j][0], v1[j][1]) | ((unsigned long long)cvtpk(v1[j][2], v1[j][3]) << 32); }
        s0 = wave_sum(s0); s1 = wave_sum(s1);
        if (lane < 16) { ssq[(size_t)m * 16 + lane] = (lane == 0) ? s0 : 0.f; ssq[(size_t)m1 * 16 + lane] = (lane == 0) ? s1 : 0.f; }
    }
}

__device__ __forceinline__ void final_norm(const Args& a, int G, int bx, int wave, int lane) {
    const float* ssq = (const float*)(a.ws + WS_SSQP) + 3 * SSQ_STRIDE; const bf16_t* hb = (const bf16_t*)(a.ws + WS_XB);
    f32x4 gv[4];
#pragma unroll
    for (int j = 0; j < 2; ++j) { gv[2 * j] = *(const f32x4*)(a.in[20] + 512 * j + 8 * lane); gv[2 * j + 1] = *(const f32x4*)(a.in[20] + 512 * j + 8 * lane + 4); }
    pg8::StaticOrder S; S.init(NTOK, DM, G, bx); pg8::Unit u;
    for (int i = 0; S.next(i, u); ++i) {
        const int m0 = u.pm * 256 + u.pn * 64 + wave * 8;
        float sp[8]; u32x4 pv[8][2];
#pragma unroll
        for (int rr = 0; rr < 8; ++rr) { sp[rr] = (lane < 16) ? ssq[(size_t)(m0 + rr) * 16 + lane] : 0.f;
#pragma unroll
            for (int j = 0; j < 2; ++j) pv[rr][j] = *(const u32x4*)(hb + (size_t)(m0 + rr) * DM + 512 * j + 8 * lane); }
#pragma unroll
        for (int rr = 0; rr < 8; ++rr) {
            const int m = m0 + rr;
            const float r = __builtin_amdgcn_rsqf(wave_sum(sp[rr]) * (1.0f / 1024.0f) + 1e-5f);
#pragma unroll
            for (int j = 0; j < 2; ++j) { const u32x4 p = pv[rr][j];
                const f32x4 v0 = (f32x4){__builtin_bit_cast(float, p.x << 16), __builtin_bit_cast(float, p.x & 0xffff0000u), __builtin_bit_cast(float, p.y << 16), __builtin_bit_cast(float, p.y & 0xffff0000u)};
                const f32x4 v1 = (f32x4){__builtin_bit_cast(float, p.z << 16), __builtin_bit_cast(float, p.z & 0xffff0000u), __builtin_bit_cast(float, p.w << 16), __builtin_bit_cast(float, p.w & 0xffff0000u)};
                float* o = a.out + (size_t)m * DM + 512 * j + 8 * lane;
                *(f32x4*)o = v0 * r * gv[2 * j]; *(f32x4*)(o + 4) = v1 * r * gv[2 * j + 1]; }
        }
    }
}

namespace att {
constexpr int KVS = 320;
#ifndef KSTR
#define KSTR 288
#endif
constexpr int KS = KSTR;
constexpr int TILE_B = 64 * KVS;
constexpr int OFF_SCR = 6 * TILE_B;
constexpr int OFF_FLAG = OFF_SCR + 2048;
constexpr int OSTR = 129;
constexpr float C2_DA = 0.125f * 1.4426950408889634f;
constexpr float C2_SB = 0.08838834764831845f * 1.4426950408889634f;
#ifndef SB_EARLY_EXIT
#define SB_EARLY_EXIT 1
#endif
constexpr float SB_RTHR = 64.0f;

__device__ __forceinline__ int crow(int r, int hi) { return (r & 3) + 8 * (r >> 2) + 4 * hi; }
__device__ __forceinline__ v4i16_t vtr(LAS const unsigned char* p) { return __builtin_amdgcn_ds_read_tr16_b64_v4i16((LAS v4i16_t*)p); }

__device__ __forceinline__ void stage_load(u32x4 (&st)[4], const bf16_t* Kg, const bf16_t* Vg, int key0, int tid) {
#pragma unroll
    for (int i = 0; i < 2; ++i) { const int c = tid + 512 * i, row = c >> 4, cc = c & 15; const size_t off = (size_t)(key0 + row) * 512 + 8 * cc;
        st[i] = *(const u32x4*)(Kg + off); st[2 + i] = *(const u32x4*)(Vg + off); }
}
__device__ __forceinline__ void stage_store(LAS unsigned char* lds, int buf, const u32x4 (&st)[4], int tid) {
#pragma unroll
    for (int i = 0; i < 2; ++i) { const int c = tid + 512 * i, row = c >> 4, cc = c & 15; LAS unsigned char* pk = lds + buf * 2 * TILE_B + row * KS + cc * 16; LAS unsigned char* pv = lds + buf * 2 * TILE_B + TILE_B + row * KVS + cc * 16;
        *(LAS u32x4*)pk = st[i]; *(LAS u32x4*)pv = st[2 + i]; }
}
__device__ __forceinline__ void pv_tile(f32x16 (&o)[4], const u32x4 (&pk)[4], LAS const unsigned char* Vb, int lane) {
    const int hi = lane >> 5;
    LAS const unsigned char* vp = Vb + (4 * hi + ((lane & 15) >> 2)) * KVS + (((lane >> 4) & 1) * 16 + (lane & 3) * 4) * 2;
#pragma unroll
    for (int db = 0; db < 4; ++db)
#pragma unroll
        for (int ks = 0; ks < 4; ++ks) {
            const v4i16_t lo = vtr(vp + (16 * ks) * KVS + db * 64), hh = vtr(vp + (16 * ks + 8) * KVS + db * 64);
            const bf16x8 vb = (bf16x8){lo[0], lo[1], lo[2], lo[3], hh[0], hh[1], hh[2], hh[3]};
            o[db] = __builtin_amdgcn_mfma_f32_32x32x16_bf16(__builtin_bit_cast(bf16x8, pk[ks]), vb, o[db], 0, 0, 0);
        }
}

__device__ __forceinline__ void diff_unit(LAS unsigned char* lds, const bf16_t* Q, const bf16_t* K, const bf16_t* V, bf16_t* A, int b, int h, int qb, float lam, const float* subln) {
    int tid_ = threadIdx.x; asm volatile("" : "+v"(tid_));
    const int tid = tid_, lane = tid & 63, r32 = lane & 31, hi = lane >> 5; const int wid = __builtin_amdgcn_readfirstlane(tid >> 6);
    const int g = wid >> 1, m = wid & 1;
    const size_t rowbase = (size_t)b * SEQ; const int q0 = qb * 128;
    const float sl2 = __builtin_amdgcn_exp2f(-2.0f * (float)(h + 1)) * 1.4426950408889634f;
    const bf16_t* Kg = K + rowbase * 512 + 128 * h; const bf16_t* Vg = V + rowbase * 512 + 128 * h;
    const int NT = (q0 + 128) / 64;
    u32x4 st[4];
    stage_load(st, Kg, Vg, (NT - 1) * 64, tid);
    bf16x8 qf[4];
    { const bf16_t* Qw = Q + (rowbase + q0 + 32 * g + r32) * 512 + 128 * h + 64 * m + 8 * hi;
#pragma unroll
      for (int d0 = 0; d0 < 4; ++d0) qf[d0] = *(const bf16x8*)(Qw + 16 * d0); }
    stage_store(lds, 0, st, tid);
    __syncthreads();
    LAS float* scr = (LAS float*)(lds + OFF_SCR) + wid * 64;
    const int qmin = q0 + 32 * g, qmax = qmin + 31, qpos = qmin + r32;
    float mref = -1e30f, lsum = 0.f;
    f32x16 o[4];
#pragma unroll
    for (int i = 0; i < 4; ++i)
#pragma unroll
        for (int r = 0; r < 16; ++r) o[i][r] = 0.f;
    const float bhi = sl2 * (float)(4 * hi);
    u32x4 pkp[4]; bool have_prev = false; int prev_off = 0, buf = 0;
#pragma unroll
    for (int i = 0; i < 4; ++i) pkp[i] = (u32x4){0u, 0u, 0u, 0u};
    for (int it = 0; it < NT; ++it) {
        const int jt = NT - 1 - it, key0 = jt * 64, nbuf = (buf == 2) ? 0 : buf + 1;
        if (it + 1 < NT) stage_load(st, Kg, Vg, (jt - 1) * 64, tid);
        const bool active = (key0 <= qmax);
        LAS const unsigned char* Kb = lds + buf * 2 * TILE_B;
        f32x16 p0, p1;
#pragma unroll
        for (int r = 0; r < 16; ++r) { p0[r] = 0.f; p1[r] = 0.f; }
        if (active) {
#pragma unroll
            for (int d0 = 0; d0 < 4; ++d0) {
                const bf16x8 k0 = *(LAS const bf16x8*)(Kb + r32 * KS + (64 * m + 16 * d0 + 8 * hi) * 2);
                const bf16x8 k1 = *(LAS const bf16x8*)(Kb + (32 + r32) * KS + (64 * m + 16 * d0 + 8 * hi) * 2);
                p0 = __builtin_amdgcn_mfma_f32_32x32x16_bf16(k0, qf[d0], p0, 0, 0, 0);
                p1 = __builtin_amdgcn_mfma_f32_32x32x16_bf16(k1, qf[d0], p1, 0, 0, 0);
            }
        }
        if (have_prev) pv_tile(o, pkp, lds + prev_off + TILE_B, lane);
        if (active) {
            const float shift = sl2 * (float)(key0 - q0) + bhi;
            const bool needmask = (key0 + 63 > qmin); const int kk0 = key0 + 4 * hi;
            float rm = -INFINITY;
#pragma unroll
            for (int r = 0; r < 16; ++r) {
                const int kv = (r & 3) + 8 * (r >> 2);
                float s0 = __builtin_fmaf(sl2, (float)kv, p0[r]), s1 = __builtin_fmaf(sl2, (float)(kv + 32), p1[r]);
                if (needmask) { if (kk0 + kv > qpos) s0 = -INFINITY; if (kk0 + kv + 32 > qpos) s1 = -INFINITY; }
                p0[r] = s0; p1[r] = s1; rm = fmaxf(rm, fmaxf(s0, s1));
            }
            rm += shift; rm = fmaxf(rm, __shfl_xor(rm, 32));
            if (__any(rm > mref + 8.0f)) {
                const float mnew = fmaxf(mref, rm); const float f = __builtin_amdgcn_exp2f(mref - mnew);
                lsum *= f; mref = mnew;
                if (hi == 0) scr[r32] = f;
                __builtin_amdgcn_wave_barrier();
#pragma unroll
                for (int r = 0; r < 16; ++r) { const float fr_ = scr[crow(r, hi)];
#pragma unroll
                    for (int db = 0; db < 4; ++db) o[db][r] *= fr_; }
                __builtin_amdgcn_wave_barrier();
            }
            const float msh = mref - shift; float ls = 0.f;
#pragma unroll
            for (int r = 0; r < 16; ++r) { p0[r] = __builtin_amdgcn_exp2f(p0[r] - msh); p1[r] = __builtin_amdgcn_exp2f(p1[r] - msh); ls += p0[r] + p1[r]; }
            lsum += ls;
            pkp[0] = (u32x4){cvtpk(p0[0], p0[1]), cvtpk(p0[2], p0[3]), cvtpk(p0[4], p0[5]), cvtpk(p0[6], p0[7])};
            pkp[1] = (u32x4){cvtpk(p0[8], p0[9]), cvtpk(p0[10], p0[11]), cvtpk(p0[12], p0[13]), cvtpk(p0[14], p0[15])};
            pkp[2] = (u32x4){cvtpk(p1[0], p1[1]), cvtpk(p1[2], p1[3]), cvtpk(p1[4], p1[5]), cvtpk(p1[6], p1[7])};
            pkp[3] = (u32x4){cvtpk(p1[8], p1[9]), cvtpk(p1[10], p1[11]), cvtpk(p1[12], p1[13]), cvtpk(p1[14], p1[15])};
            have_prev = true; prev_off = buf * 2 * TILE_B;
        }
        if (it + 1 < NT) stage_store(lds, nbuf, st, tid);
        buf = nbuf;
        __syncthreads();
    }
    if (have_prev) pv_tile(o, pkp, lds + prev_off + TILE_B, lane);
    __syncthreads();
    lsum += __shfl_xor(lsum, 32);
    if (hi == 0) scr[r32] = lsum;
    __builtin_amdgcn_wave_barrier();
    LAS float* Ob = (LAS float*)lds;
    const float fac = (m == 0) ? 1.0f : -lam;
    float rl[16];
#pragma unroll
    for (int r = 0; r < 16; ++r) rl[r] = fac / scr[crow(r, hi)];
    if (m == 1) {
#pragma unroll
        for (int r = 0; r < 16; ++r)
#pragma unroll
            for (int db = 0; db < 4; ++db) Ob[(32 * g + crow(r, hi)) * OSTR + 32 * db + r32] = o[db][r] * rl[r];
    }
    __syncthreads();
    if (m == 0) {
#pragma unroll
        for (int r = 0; r < 16; ++r)
#pragma unroll
            for (int db = 0; db < 4; ++db) { LAS float* p = Ob + (32 * g + crow(r, hi)) * OSTR + 32 * db + r32; *p = *p + o[db][r] * rl[r]; }
    }
    __syncthreads();
    {
        const int row = tid >> 2, part = tid & 3; const LAS float* src = Ob + row * OSTR + 32 * part;
        float v[32]; float ss = 0.f;
#pragma unroll
        for (int i = 0; i < 32; ++i) { v[i] = src[i]; ss += v[i] * v[i]; }
        ss += __shfl_xor(ss, 1); ss += __shfl_xor(ss, 2);
        const float rs = 0.8f / sqrtf(ss * (1.0f / 128.0f) + 1e-5f);
        const f32x4* gp = (const f32x4*)(subln + 32 * part);
        bf16_t* dst = A + (rowbase + q0 + row) * 1024 + 128 * h + 32 * part;
#pragma unroll
        for (int c = 0; c < 4; ++c) {
            const f32x4 g0 = gp[2 * c], g1 = gp[2 * c + 1];
            u32x4 w;
            w.x = cvtpk(v[8 * c + 0] * rs * g0[0], v[8 * c + 1] * rs * g0[1]); w.y = cvtpk(v[8 * c + 2] * rs * g0[2], v[8 * c + 3] * rs * g0[3]);
            w.z = cvtpk(v[8 * c + 4] * rs * g1[0], v[8 * c + 5] * rs * g1[1]); w.w = cvtpk(v[8 * c + 6] * rs * g1[2], v[8 * c + 7] * rs * g1[3]);
            *(u32x4*)(dst + 8 * c) = w;
        }
    }
    __syncthreads();
}

__device__ __forceinline__ void sb_unit(LAS unsigned char* lds, const bf16_t* Q, const bf16_t* K, const bf16_t* V, bf16_t* Bo, int b, int h, int qb) {
    int tid_ = threadIdx.x; asm volatile("" : "+v"(tid_));
    const int tid = tid_, lane = tid & 63, r32 = lane & 31, hi = lane >> 5; const int wid = __builtin_amdgcn_readfirstlane(tid >> 6);
    const size_t rowbase = (size_t)b * SEQ; const int q0 = qb * 256;
    const bf16_t* Kg = K + rowbase * 512 + 128 * h; const bf16_t* Vg = V + rowbase * 512 + 128 * h;
    const int NT = (q0 + 256) / 64;
    u32x4 st[4];
    stage_load(st, Kg, Vg, (NT - 1) * 64, tid);
    const int qmin = q0 + 32 * wid, qmax = qmin + 31, qpos = qmin + r32;
    bf16x8 qf[8];
    { const bf16_t* Qw = Q + (rowbase + qpos) * 512 + 128 * h + 8 * hi;
#pragma unroll
      for (int d0 = 0; d0 < 8; ++d0) qf[d0] = *(const bf16x8*)(Qw + 16 * d0); }
    bf16x8 tt0, tt1, ones;
#pragma unroll
    for (int j = 0; j < 8; ++j) { const int kin = (j & 3) + 8 * (j >> 2) + 4 * hi;
        tt0[j] = (kin >= r32) ? (short)0x3F80 : (short)0; tt1[j] = (16 + kin >= r32) ? (short)0x3F80 : (short)0; ones[j] = (short)0x3F80; }
    stage_store(lds, 0, st, tid);
    __syncthreads();
    volatile LAS unsigned* flags = (volatile LAS unsigned*)(lds + OFF_FLAG);
    float R = 0.f; bool wave_done = false;
    f32x16 o[4];
#pragma unroll
    for (int i = 0; i < 4; ++i)
#pragma unroll
        for (int r = 0; r < 16; ++r) o[i][r] = 0.f;
    for (int it = 0; it < NT; ++it) {
        const int jt = NT - 1 - it, buf = it & 1, key0 = jt * 64;
        if (it + 1 < NT) stage_load(st, Kg, Vg, (jt - 1) * 64, tid);
        if (key0 < qmax && !wave_done) {
            LAS const unsigned char* Kb = lds + buf * 2 * TILE_B; LAS const unsigned char* Vb = Kb + TILE_B;
            f32x16 p0, p1;
#pragma unroll
            for (int r = 0; r < 16; ++r) { p0[r] = 0.f; p1[r] = 0.f; }
#pragma unroll
            for (int d0 = 0; d0 < 8; ++d0) {
                const bf16x8 k0 = *(LAS const bf16x8*)(Kb + r32 * KS + (16 * d0 + 8 * hi) * 2);
                const bf16x8 k1 = *(LAS const bf16x8*)(Kb + (32 + r32) * KS + (16 * d0 + 8 * hi) * 2);
                p0 = __builtin_amdgcn_mfma_f32_32x32x16_bf16(k0, qf[d0], p0, 0, 0, 0);
                p1 = __builtin_amdgcn_mfma_f32_32x32x16_bf16(k1, qf[d0], p1, 0, 0, 0);
            }
            const bool needmask = (key0 + 63 >= qmin); const int kk0 = key0 + 4 * hi;
            f32x16 u0, u1;
#pragma unroll
            for (int r = 0; r < 16; ++r) {
                const int kv = (r & 3) + 8 * (r >> 2);
                float a0 = __builtin_amdgcn_logf(1.0f + __builtin_amdgcn_exp2f(p0[r])), a1 = __builtin_amdgcn_logf(1.0f + __builtin_amdgcn_exp2f(p1[r]));
                a0 = (p0[r] > 30.f) ? p0[r] : a0; a1 = (p1[r] > 30.f) ? p1[r] : a1;
                if (needmask) { if (kk0 + kv >= qpos) a0 = 0.f; if (kk0 + kv + 32 >= qpos) a1 = 0.f; }
                u0[r] = a0; u1[r] = a1;
            }
            u32x4 uk[4];
            uk[0] = (u32x4){cvtpk(u0[0], u0[1]), cvtpk(u0[2], u0[3]), cvtpk(u0[4], u0[5]), cvtpk(u0[6], u0[7])};
            uk[1] = (u32x4){cvtpk(u0[8], u0[9]), cvtpk(u0[10], u0[11]), cvtpk(u0[12], u0[13]), cvtpk(u0[14], u0[15])};
            uk[2] = (u32x4){cvtpk(u1[0], u1[1]), cvtpk(u1[2], u1[3]), cvtpk(u1[4], u1[5]), cvtpk(u1[6], u1[7])};
            uk[3] = (u32x4){cvtpk(u1[8], u1[9]), cvtpk(u1[10], u1[11]), cvtpk(u1[12], u1[13]), cvtpk(u1[14], u1[15])};
            f32x16 c0, c1;
#pragma unroll
            for (int r = 0; r < 16; ++r) { c0[r] = R; c1[r] = R; }
            c0 = __builtin_amdgcn_mfma_f32_32x32x16_bf16(tt0, __builtin_bit_cast(bf16x8, uk[0]), c0, 0, 0, 0);
            c0 = __builtin_amdgcn_mfma_f32_32x32x16_bf16(tt1, __builtin_bit_cast(bf16x8, uk[1]), c0, 0, 0, 0);
            c0 = __builtin_amdgcn_mfma_f32_32x32x16_bf16(ones, __builtin_bit_cast(bf16x8, uk[2]), c0, 0, 0, 0);
            c0 = __builtin_amdgcn_mfma_f32_32x32x16_bf16(ones, __builtin_bit_cast(bf16x8, uk[3]), c0, 0, 0, 0);
            c1 = __builtin_amdgcn_mfma_f32_32x32x16_bf16(tt0, __builtin_bit_cast(bf16x8, uk[2]), c1, 0, 0, 0);
            c1 = __builtin_amdgcn_mfma_f32_32x32x16_bf16(tt1, __builtin_bit_cast(bf16x8, uk[3]), c1, 0, 0, 0);
#pragma unroll
            for (int r = 0; r < 16; ++r) {
                const int kv = (r & 3) + 8 * (r >> 2);
                float a0 = __builtin_amdgcn_exp2f(p0[r] - c0[r]), a1 = __builtin_amdgcn_exp2f(p1[r] - c1[r]);
                if (needmask) { if (kk0 + kv >= qpos) a0 = 0.f; if (kk0 + kv + 32 >= qpos) a1 = 0.f; }
                p0[r] = a0; p1[r] = a1;
            }
            R = __shfl(c0[0], r32);
            u32x4 pk[4];
            pk[0] = (u32x4){cvtpk(p0[0], p0[1]), cvtpk(p0[2], p0[3]), cvtpk(p0[4], p0[5]), cvtpk(p0[6], p0[7])};
            pk[1] = (u32x4){cvtpk(p0[8], p0[9]), cvtpk(p0[10], p0[11]), cvtpk(p0[12], p0[13]), cvtpk(p0[14], p0[15])};
            pk[2] = (u32x4){cvtpk(p1[0], p1[1]), cvtpk(p1[2], p1[3]), cvtpk(p1[4], p1[5]), cvtpk(p1[6], p1[7])};
            pk[3] = (u32x4){cvtpk(p1[8], p1[9]), cvtpk(p1[10], p1[11]), cvtpk(p1[12], p1[13]), cvtpk(p1[14], p1[15])};
            pv_tile(o, pk, Vb, lane);
#if SB_EARLY_EXIT
            wave_done = __all(R > SB_RTHR);
#endif
        }
        if (it + 1 < NT) stage_store(lds, buf ^ 1, st, tid);
#if SB_EARLY_EXIT
        if (lane == 0) flags[buf * 8 + wid] = wave_done ? 1u : 0u;
#endif
        __syncthreads();
#if SB_EARLY_EXIT
        { unsigned all = 1u;
#pragma unroll
          for (int w = 0; w < 8; ++w) all &= flags[buf * 8 + w];
          if (all) break; }
#endif
    }
    bf16_t* dst = Bo + (rowbase + qmin) * 1024 + 128 * h + r32;
#pragma unroll
    for (int r = 0; r < 16; ++r)
#pragma unroll
        for (int db = 0; db < 4; ++db) dst[(size_t)crow(r, hi) * 1024 + 32 * db] = (bf16_t)(cvtpk(o[db][r], 0.f) & 0xffffu);
}
}

#ifndef PH
#define PH 0xFFF
#endif
#ifndef REP
#define REP 0
#endif
#define NREP(bit) ((REP & (bit)) ? 2 : 1)
#ifndef GRID_SYNC

#endif
__device__ __forceinline__ void grid_barrier(unsigned* ctr, unsigned target) {
    asm volatile("s_waitcnt vmcnt(0) lgkmcnt(0)" ::: "memory");
    __syncthreads();
    if (threadIdx.x == 0) {
        __builtin_amdgcn_fence(__ATOMIC_RELEASE, "agent");
        asm volatile("s_waitcnt vmcnt(0)" ::: "memory");
        __hip_atomic_fetch_add(ctr, 1u, __ATOMIC_RELAXED, __HIP_MEMORY_SCOPE_AGENT);
        unsigned spins = 0;
        while (__hip_atomic_load(ctr, __ATOMIC_RELAXED, __HIP_MEMORY_SCOPE_AGENT) < target) { __builtin_amdgcn_s_sleep(2); if (++spins > (1u << 24)) break; }
        __builtin_amdgcn_fence(__ATOMIC_ACQUIRE, "agent");
        asm volatile("s_waitcnt vmcnt(0)" ::: "memory");
    }
    __syncthreads();
}
__device__ __forceinline__ void grid_barrier2(unsigned* ctl, unsigned x, unsigned nloc, unsigned nx, unsigned round) {
    asm volatile("s_waitcnt vmcnt(0) lgkmcnt(0)" ::: "memory");
    __syncthreads();
    if (threadIdx.x == 0) {
        const unsigned old = __hip_atomic_fetch_add(ctl + 2048 + 64 * x, 1u, __ATOMIC_RELAXED, __HIP_MEMORY_SCOPE_AGENT);
        if (old + 1u == round * nloc) {
            __builtin_amdgcn_fence(__ATOMIC_RELEASE, "agent");
            asm volatile("s_waitcnt vmcnt(0)" ::: "memory");
            __hip_atomic_fetch_add(ctl + 1280, 1u, __ATOMIC_RELAXED, __HIP_MEMORY_SCOPE_AGENT);
        }
        asm volatile("buffer_inv sc1" ::: "memory");
        unsigned spins = 0;
        while (__hip_atomic_load(ctl + 1280, __ATOMIC_RELAXED, __HIP_MEMORY_SCOPE_AGENT) < round * nx) { if (++spins > (1u << 26)) break; }
        asm volatile("s_waitcnt vmcnt(0)" ::: "memory");
    }
    __syncthreads();
}
#define GRID_SYNC() do { if (two_level) { ++nsync2; grid_barrier2((unsigned*)a.ws, xcd_x, xcd_nloc, 8u, nsync2); } else { ++nsync; grid_barrier((unsigned*)a.ws, nsync * (unsigned)G); } } while (0)
__device__ __forceinline__ float bf_f(bf16_t v) { return __builtin_bit_cast(float, (unsigned)v << 16); }
__global__ void __launch_bounds__(512, 2) mega_fwd(Args a) {
    extern __shared__ __attribute__((aligned(16))) unsigned char lds_raw[];
    LAS unsigned char* lds = (LAS unsigned char*)lds_raw;
    cg::grid_group grid = cg::this_grid();
    const int tid = threadIdx.x, lane = tid & 63; const int wave = __builtin_amdgcn_readfirstlane(tid >> 6);
    const int G = gridDim.x, NGW = G * 8;
    unsigned nsync = 0;
    if (blockIdx.x == 0) for (int i = tid; i < 4096; i += 512) __hip_atomic_store((unsigned*)a.ws + i, 0u, __ATOMIC_RELAXED, __HIP_MEMORY_SCOPE_AGENT);
    asm volatile("s_waitcnt vmcnt(0)" ::: "memory");
    grid.sync();
    int bx; unsigned nsync2 = 0, xcd_x = 0, xcd_nloc = 1; bool two_level = false;
    unsigned char* ws = a.ws;
    { unsigned* ctl = (unsigned*)a.ws; volatile LAS unsigned* misc = (volatile LAS unsigned*)(lds + LDS_BYTES - 64);
      if (tid == 0) { const unsigned x = (unsigned)__builtin_amdgcn_s_getreg((3 << 11) | 20) & 0xFu;
                      misc[0] = x; misc[1] = __hip_atomic_fetch_add(ctl + 64 + 64 * x, 1u, __ATOMIC_RELAXED, __HIP_MEMORY_SCOPE_AGENT);
                      unsigned spins = 0;
                      for (;;) { unsigned sum = 0; for (unsigned j = 0; j < 16; ++j) sum += __hip_atomic_load(ctl + 64 + 64 * j, __ATOMIC_RELAXED, __HIP_MEMORY_SCOPE_AGENT);
                                 if (sum >= (unsigned)G || ++spins > (1u << 22)) break; __builtin_amdgcn_s_sleep(2); } }
      __syncthreads();
      const unsigned x = misc[0], rank = misc[1]; unsigned nx = 0, base = 0; bool equal = true;
      for (unsigned j = 0; j < 16; ++j) { const unsigned c = __hip_atomic_load(ctl + 64 + 64 * j, __ATOMIC_RELAXED, __HIP_MEMORY_SCOPE_AGENT);
          if (c) { ++nx; if (c != (unsigned)G / 8u) equal = false; } if (j < x) base += c; }
      const bool regular = equal && nx == 8 && x < 8;
      bx = __builtin_amdgcn_readfirstlane(regular ? (int)(rank * 8 + x) : (int)(base + rank));
      two_level = regular; xcd_x = (unsigned)__builtin_amdgcn_readfirstlane((int)x); xcd_nloc = (unsigned)G / 8u;
      prologue(a, lds, bx * 8 + wave, NGW, wave, lane);
      GRID_SYNC(); }
    const int gw = bx * 8 + wave;
    const int vcu = (G % 8 == 0) ? (bx % 8) * (G / 8) + bx / 8 : bx;
    float* ssq = (float*)(ws + WS_SSQP);
    bf16_t* xb = (bf16_t*)(ws + WS_XB); bf16_t* U = (bf16_t*)(ws + WS_BIG); bf16_t* qkv = (bf16_t*)(ws + WS_BIG);
    bf16_t* gates = (bf16_t*)(ws + WS_GATES); bf16_t* yb = (bf16_t*)(ws + WS_Y);
    bf16_t* ao = (bf16_t*)a.out; bf16_t* bo = ao + 512;

    for (int rep = 0; rep < NREP(2); ++rep) {
    if (PH & 2) { pg8::Gemm g{xb, (const bf16_t*)(ws + WS_WGU1), NTOK, 2 * DFF, DM}; pg8::StaticOrder S; S.init(NTOK, 2 * DFF, G, bx);
      pg8::EpiSwiGLU E{U, DFF, ssq};
      pg8::gemm_phase<pg8::EpiSwiGLU, pg8::StaticOrder, true, true>(lds, g, S, E);
      if (G == 256 && bx >= 128) prologue_items(a, lds, PI_E1, PI_E3, (bx - 128) * 8 + wave, 128 * 8, wave, lane);
      else if (G != 256) prologue_items(a, lds, PI_E1, PI_E3, gw, NGW, wave, lane); }
    GRID_SYNC(); }
    for (int rep = 0; rep < NREP(4); ++rep) {
    if (PH & 4) { pg8::Gemm g{U, (const bf16_t*)(ws + WS_WD1), NTOK, DM, DFF}; pg8::StaticOrder S; S.init(NTOK, DM, G, bx);
      pg8::EpiResidB E{nullptr, xb, ssq + SSQ_STRIDE, 0.5f};
      pg8::gemm_phase<pg8::EpiResidB, pg8::StaticOrder, true, true>(lds, g, S, E); }
    GRID_SYNC(); }
    for (int rep = 0; rep < NREP(8); ++rep) {
    if (PH & 8) { pg8::Gemm g{xb, (const bf16_t*)(ws + WS_WIN), NTOK, DIN, DM}; pg8::StaticOrder S; S.init(NTOK, DIN, G, bx);
      pg8::EpiProj E{qkv, gates, ssq + SSQ_STRIDE, a.in[7], att::C2_DA, att::C2_SB};
      pg8::gemm_phase<pg8::EpiProj, pg8::StaticOrder, true, true>(lds, g, S, E); }
    GRID_SYNC(); }
    if (PH & 16) {
        float lam;
        { const float s1 = wave_sum(a.in[8][lane] * a.in[9][lane]), s2 = wave_sum(a.in[10][lane] * a.in[11][lane]); lam = expf(s1) - expf(s2) + 0.2f; }
        for (int rep = 0; rep < NREP(1024); ++rep) if (PH & 1024) for (int pu = vcu; pu < 256; pu += G) { const int bh = pu >> 4, j = pu & 15, b = bh >> 2, h = bh & 3;
            att::diff_unit(lds, qkv, qkv + QKV_ELEMS, qkv + 2 * QKV_ELEMS, ao, b, h, 31 - j, lam, a.in[12]);
            att::diff_unit(lds, qkv, qkv + QKV_ELEMS, qkv + 2 * QKV_ELEMS, ao, b, h, j, lam, a.in[12]); }
        for (int rep = 0; rep < NREP(2048); ++rep) if (PH & 2048) for (int u = vcu; u < 256; u += G) { const int bh = u >> 4, qb = u & 15, b = bh >> 2, h = bh & 3;
            att::sb_unit(lds, qkv + 3 * QKV_ELEMS, qkv + 4 * QKV_ELEMS, qkv + 5 * QKV_ELEMS, bo, b, h, qb); }
    }
    GRID_SYNC();
    if (PH & 32) { pg8::Gemm g{ao, (const bf16_t*)(ws + WS_WAB), NTOK, 2 * DM, DM}; pg8::StaticOrder S; S.init(NTOK, 2 * DM, G, bx);
      pg8::EpiBranch2 E{yb, gates};
      pg8::gemm_phase<pg8::EpiBranch2, pg8::StaticOrder, true, true>(lds, g, S, E); }
    GRID_SYNC();
    if (PH & 64) { pg8::Gemm g{yb, (const bf16_t*)(ws + WS_WOUT), NTOK, DM, DM}; pg8::StaticOrder S; S.init(NTOK, DM, G, bx);
      pg8::EpiResidB E{nullptr, xb, ssq + 2 * SSQ_STRIDE, 1.0f};
      pg8::gemm_phase<pg8::EpiResidB, pg8::StaticOrder, true, true>(lds, g, S, E); }
    GRID_SYNC();
    if (PH & 128) { pg8::Gemm g{xb, (const bf16_t*)(ws + WS_WGU2), NTOK, 2 * DFF, DM}; pg8::StaticOrder S; S.init(NTOK, 2 * DFF, G, bx);
      pg8::EpiSwiGLU E{U, DFF, ssq + 2 * SSQ_STRIDE};
      pg8::gemm_phase<pg8::EpiSwiGLU, pg8::StaticOrder, true, true>(lds, g, S, E);
      if (G == 256 && bx >= 128) prologue_items(a, lds, PI_E8, PI_TOTAL, (bx - 128) * 8 + wave, 128 * 8, wave, lane);
      else if (G != 256) prologue_items(a, lds, PI_E8, PI_TOTAL, gw, NGW, wave, lane); }
    GRID_SYNC();
    if (PH & 256) { pg8::Gemm g{U, (const bf16_t*)(ws + WS_WD2), NTOK, DM, DFF}; pg8::StaticOrder S; S.init(NTOK, DM, G, bx);
      pg8::EpiResidB E{nullptr, xb, ssq + 3 * SSQ_STRIDE, 0.5f};
      pg8::gemm_phase<pg8::EpiResidB, pg8::StaticOrder, true, true>(lds, g, S, E); }
    GRID_SYNC();
    if (PH & 512) final_norm(a, G, bx, wave, lane);
#ifdef DBG_FINAL
    for (size_t i = (size_t)bx * 512 + tid; i < (size_t)NTOK * DM; i += (size_t)G * 512) {
        const int row = (int)(i >> 10), c = (int)(i & 1023), cc = c & 511, o = (c >> 9) * 3;
        float v = 0.f;
        if (DBG_FINAL == 1) v = bf_f(qkv[(size_t)(o + 0) * QKV_ELEMS + (size_t)row * 512 + cc]) + bf_f(qkv[(size_t)(o + 1) * QKV_ELEMS + (size_t)row * 512 + cc]) + bf_f(qkv[(size_t)(o + 2) * QKV_ELEMS + (size_t)row * 512 + cc])
                                + bf_f(gates[(size_t)row * 2048 + c]) + bf_f(gates[(size_t)row * 2048 + 1024 + c]);
        if (DBG_FINAL == 4) v = bf_f(gates[(size_t)row * 2048 + c]) + bf_f(gates[(size_t)row * 2048 + 1024 + c]);
        if (DBG_FINAL == 5) v = bf_f(qkv[(size_t)(o + 0) * QKV_ELEMS + (size_t)row * 512 + cc]) + bf_f(qkv[(size_t)(o + 1) * QKV_ELEMS + (size_t)row * 512 + cc]) + bf_f(qkv[(size_t)(o + 2) * QKV_ELEMS + (size_t)row * 512 + cc]);
        if (DBG_FINAL == 6) v = bf_f(U[(size_t)row * 2816 + c]) + bf_f(U[(size_t)row * 2816 + 1024 + c]) + (c < 768 ? bf_f(U[(size_t)row * 2816 + 2048 + c]) : 0.f);
        if (DBG_FINAL == 7) v = (row < 5120) ? bf_f(((const bf16_t*)(ws + WS_WIN))[(size_t)row * 1024 + c]) : 0.f;
        if (DBG_FINAL == 8) v = bf_f(ao[(size_t)row * 1024 + c]);
        if (DBG_FINAL == 9) v = (c < 512) ? bf_f(ao[(size_t)row * 512 + cc]) : 0.f;
        if (DBG_FINAL == 10) v = (c < 512) ? 0.f : bf_f(bo[(size_t)row * 512 + cc]);
        if (DBG_FINAL == 2) v = bf_f(yb[(size_t)row * 1024 + c]);
        if (DBG_FINAL == 3) v = bf_f(xb[i]) + ssq[SSQ_STRIDE + (size_t)row * 16 + (c & 15)];
        a.out[i] = v;
    }
#endif
}

extern "C" void kernel_launch(void* const* d_in, const int* in_sizes, int n_in, void* d_out, int out_size, void* d_ws, size_t ws_size, hipStream_t stream) {
    static int grid = 0;
    if (grid == 0) {
        if (n_in != 21 || out_size != NTOK * DM || ws_size < WS_END) { fprintf(stderr, "kernel_launch: unexpected problem shape (n_in %d out %d ws %zu)\n", n_in, out_size, ws_size); grid = -1; return; }
        int dev = 0, cus = 0, per_cu = 0;
        (void)hipGetDevice(&dev); (void)hipDeviceGetAttribute(&cus, hipDeviceAttributeMultiprocessorCount, dev);
        (void)hipFuncSetAttribute((const void*)mega_fwd, hipFuncAttributeMaxDynamicSharedMemorySize, LDS_BYTES);
        if (hipOccupancyMaxActiveBlocksPerMultiprocessor(&per_cu, (const void*)mega_fwd, 512, LDS_BYTES) != hipSuccess || per_cu < 1) per_cu = 1;
        (void)hipGetLastError();
        if (cus <= 0) cus = 256;
        grid = cus * per_cu;
    }
    if (grid < 0) return;
    Args a{};
    for (int i = 0; i < 21; ++i) a.in[i] = (const float*)d_in[i];
    a.out = (float*)d_out; a.ws = (unsigned char*)d_ws;
    void* args[] = {&a};
    hipError_t e = hipLaunchCooperativeKernel((const void*)mega_fwd, dim3(grid), dim3(512), args, LDS_BYTES, stream);
    if (e != hipSuccess) fprintf(stderr, "cooperative launch failed: %s (grid %d)\n", hipGetErrorString(e), grid);
}
```
